# Optimizing an MI355X kernel written in HIP

```python
import jax
import jax.numpy as jnp
from jax import lax
import numpy as np

D_MODEL = 1024
BATCH = 8
SEQ = 2048
DEPTH = 2

GRID_W = 64
CTX_LEN = 256
N_HEADS = 8
QK_NOPE = 64
QK_ROPE = 32
QK_HEAD = QK_NOPE + QK_ROPE
V_HEAD = 64
Q_LORA = 384
KV_LORA = 256
ROPE_BASE = 10000.0
Q_BLOCK = 128
CONV_CH = 256
CONV_WIDTH = 31
CONV_PAD = (CONV_WIDTH - 1) // 2
FOURIER_GROUPS = 4
FOURIER_GROUP_DIM = 64
FOURIER_CH = FOURIER_GROUPS * FOURIER_GROUP_DIM
ATTN_OUT = N_HEADS * V_HEAD
MIX_WIDTH = ATTN_OUT + CONV_CH + FOURIER_CH
OFF_CQ = 0
OFF_CKV = OFF_CQ + Q_LORA
OFF_KR = OFF_CKV + KV_LORA
OFF_CONV = OFF_KR + QK_ROPE
OFF_FOUR = OFF_CONV + 2 * CONV_CH
IN_COLS = OFF_FOUR + FOURIER_CH
D_FF = 2816
N_EXPERTS = 8
TOP_K = 2
N_DENSE = (DEPTH + 1) // 2
N_MOE = DEPTH // 2
N_MOD = 6
EPS = 1e-6

kernel_name = 'hybrid_mla_conformer_fnet_moe_dit'


def _rmsnorm(x, g):
    xf = x.astype(jnp.float32)
    y = xf * lax.rsqrt(jnp.mean(xf * xf, axis=-1, keepdims=True) + EPS)
    return (y * g.astype(jnp.float32)).astype(x.dtype)


def _layernorm(x, g, b):
    xf = x.astype(jnp.float32)
    mu = jnp.mean(xf, axis=-1, keepdims=True)
    var = jnp.mean(jnp.square(xf - mu), axis=-1, keepdims=True)
    y = (xf - mu) * lax.rsqrt(var + EPS)
    return (y * g.astype(jnp.float32) + b.astype(jnp.float32)).astype(x.dtype)


def _modulation(cvec, w, b):
    m = jax.nn.silu(cvec) @ w + b
    return [p[:, None, :] for p in jnp.split(m, N_MOD, axis=-1)]


def _adaln(x, g, shift, scale):
    return _rmsnorm(x, g) * (1 + scale) + shift


def _axial_rope(rows):
    row = jnp.repeat(jnp.arange(rows, dtype=jnp.float32), GRID_W)
    col = jnp.tile(jnp.arange(GRID_W, dtype=jnp.float32), rows)
    n_freq = QK_ROPE // 4
    inv = ROPE_BASE ** (-jnp.arange(n_freq, dtype=jnp.float32) / n_freq)
    ang = jnp.concatenate([row[:, None] * inv, col[:, None] * inv], axis=-1)
    return jnp.cos(ang), jnp.sin(ang)


def _apply_rope(x, rope):
    if rope is None:
        return x
    cos, sin = rope
    cos = cos[:, None, :]
    sin = sin[:, None, :]
    xf = x.astype(jnp.float32)
    x1, x2 = jnp.split(xf, 2, axis=-1)
    return jnp.concatenate([x1 * cos - x2 * sin, x2 * cos + x1 * sin], axis=-1).astype(x.dtype)


def _mla_queries(cq, w_uq, q_lat_g, q_norm_g, rope):
    b, s, _ = cq.shape
    q = (_rmsnorm(cq, q_lat_g) @ w_uq).reshape(b, s, N_HEADS, QK_HEAD)
    q = _rmsnorm(q, q_norm_g)
    return jnp.concatenate([q[..., :QK_NOPE], _apply_rope(q[..., QK_NOPE:], rope)], axis=-1)


def _mla_keys_values(ckv, kr, w_ukv, kv_lat_g, k_norm_g, rope):
    b, s, _ = ckv.shape
    kv = (_rmsnorm(ckv, kv_lat_g) @ w_ukv).reshape(b, s, N_HEADS, QK_NOPE + V_HEAD)
    k_rope = jnp.broadcast_to(kr[:, :, None, :], (b, s, N_HEADS, QK_ROPE))
    k = _rmsnorm(jnp.concatenate([kv[..., :QK_NOPE], k_rope], axis=-1), k_norm_g)
    k = jnp.concatenate([k[..., :QK_NOPE], _apply_rope(k[..., QK_NOPE:], rope)], axis=-1)
    return k, kv[..., QK_NOPE:]


def _attend(q, k, v):
    b, s, h, d = q.shape
    nb = s // Q_BLOCK
    scale = d ** -0.5
    qb = jnp.moveaxis(q.reshape(b, nb, Q_BLOCK, h, d), 1, 0)

    def block(qblk):
        sc = jnp.einsum('bqhd,bkhd->bhqk', qblk, k).astype(jnp.float32) * scale
        p = jax.nn.softmax(sc, axis=-1).astype(v.dtype)
        return jnp.einsum('bhqk,bkhd->bqhd', p, v)

    o = lax.map(block, qb)
    return jnp.moveaxis(o, 0, 1).reshape(b, s, h * v.shape[-1])


def _conformer_conv(u, conv_w, conv_b, ln_g, ln_b):
    a, g = jnp.split(u, 2, axis=-1)
    y = a * jax.nn.sigmoid(g)
    y = lax.conv_general_dilated(
        y, conv_w[:, None, :], window_strides=(1,), padding=[(CONV_PAD, CONV_PAD)],
        dimension_numbers=('NWC', 'WIO', 'NWC'), feature_group_count=CONV_CH) + conv_b
    return jax.nn.silu(_layernorm(y, ln_g, ln_b))


def _fourier_mix(u):
    b, s, _ = u.shape
    z = u.astype(jnp.float32).reshape(b, s, FOURIER_GROUPS, FOURIER_GROUP_DIM)
    f = jnp.real(jnp.fft.fft2(z, axes=(1, 3), norm='ortho'))
    return f.reshape(b, s, FOURIER_CH).astype(u.dtype)


def _mixer_out(cols, k, v, rope, w_uq, q_lat_g, q_norm_g, conv_w, conv_b, conv_ln_g, conv_ln_b, w_out):
    q = _mla_queries(cols[..., OFF_CQ:OFF_CKV], w_uq, q_lat_g, q_norm_g, rope)
    attn = _attend(q, k, v)
    conv = _conformer_conv(cols[..., OFF_CONV:OFF_FOUR], conv_w, conv_b, conv_ln_g, conv_ln_b)
    four = _fourier_mix(cols[..., OFF_FOUR:IN_COLS])
    return jnp.concatenate([attn, conv, four], axis=-1) @ w_out


def _swiglu(h, wg, wu, wd):
    return (jax.nn.silu(h @ wg) * (h @ wu)) @ wd


def _moe_swiglu(h, router_w, wg, wu, wd):
    b, s, d = h.shape
    t = h.reshape(b * s, d)
    logits = (t @ router_w).astype(jnp.float32)
    top_v, top_i = lax.top_k(logits, TOP_K)
    w = jax.nn.softmax(top_v, axis=-1)
    gates = jnp.einsum('nk,nke->ne', w, jax.nn.one_hot(top_i, N_EXPERTS, dtype=jnp.float32)).astype(h.dtype)
    out = jnp.zeros_like(t)
    for e in range(N_EXPERTS):
        out = out + gates[:, e:e + 1] * _swiglu(t, wg[e], wu[e], wd[e])
    return out.reshape(b, s, d)


def _channel_mixer(h, layer, ffn_w_gate, ffn_w_up, ffn_w_down, router_w, moe_w_gate, moe_w_up, moe_w_down):
    i = layer // 2
    if layer % 2 == 0:
        return _swiglu(h, ffn_w_gate[i], ffn_w_up[i], ffn_w_down[i])
    return _moe_swiglu(h, router_w[i], moe_w_gate[i], moe_w_up[i], moe_w_down[i])


def _normal(k, shape, scale):
    return jax.random.normal(k, shape, jnp.float32) * scale


def setup_inputs(seed: int = 0) -> dict:
    key = jax.random.key(seed)
    ks = jax.random.split(key, 32)
    D = D_MODEL
    return {
        'x': _normal(ks[0], (BATCH, SEQ, D), 1.0),
        'c': _normal(ks[1], (BATCH, D), 1.0),
        'ctx': _normal(ks[2], (BATCH, CTX_LEN, D), 1.0),
        'c_ctx': _normal(ks[3], (D,), 1.0),
        'ada_w': _normal(ks[4], (DEPTH, D, N_MOD * D), 0.5 * D ** -0.5),
        'ada_b': _normal(ks[5], (DEPTH, N_MOD * D), 0.02),
        'mix_norm_g': 1.0 + _normal(ks[6], (DEPTH, D), 0.05),
        'ffn_norm_g': 1.0 + _normal(ks[7], (DEPTH, D), 0.05),
        'w_in': _normal(ks[8], (DEPTH, D, IN_COLS), D ** -0.5),
        'q_lat_g': 1.0 + _normal(ks[9], (DEPTH, Q_LORA), 0.05),
        'kv_lat_g': 1.0 + _normal(ks[10], (DEPTH, KV_LORA), 0.05),
        'w_uq': _normal(ks[11], (DEPTH, Q_LORA, N_HEADS * QK_HEAD), Q_LORA ** -0.5),
        'w_ukv': _normal(ks[12], (DEPTH, KV_LORA, N_HEADS * (QK_NOPE + V_HEAD)), KV_LORA ** -0.5),
        'q_norm_g': 1.0 + _normal(ks[13], (DEPTH, QK_HEAD), 0.05),
        'k_norm_g': 1.0 + _normal(ks[14], (DEPTH, QK_HEAD), 0.05),
        'conv_w': _normal(ks[15], (DEPTH, CONV_WIDTH, CONV_CH), CONV_WIDTH ** -0.5),
        'conv_b': _normal(ks[16], (DEPTH, CONV_CH), 0.02),
        'conv_ln_g': 1.0 + _normal(ks[17], (DEPTH, CONV_CH), 0.05),
        'conv_ln_b': _normal(ks[18], (DEPTH, CONV_CH), 0.02),
        'w_out': _normal(ks[19], (DEPTH, MIX_WIDTH, D), MIX_WIDTH ** -0.5),
        'ffn_w_gate': _normal(ks[20], (N_DENSE, D, D_FF), D ** -0.5),
        'ffn_w_up': _normal(ks[21], (N_DENSE, D, D_FF), D ** -0.5),
        'ffn_w_down': _normal(ks[22], (N_DENSE, D_FF, D), D_FF ** -0.5),
        'router_w': _normal(ks[23], (N_MOE, D, N_EXPERTS), D ** -0.5),
        'moe_w_gate': _normal(ks[24], (N_MOE, N_EXPERTS, D, D_FF), D ** -0.5),
        'moe_w_up': _normal(ks[25], (N_MOE, N_EXPERTS, D, D_FF), D ** -0.5),
        'moe_w_down': _normal(ks[26], (N_MOE, N_EXPERTS, D_FF, D), D_FF ** -0.5),
    }


def reference(x, c, ctx, c_ctx, ada_w, ada_b, mix_norm_g, ffn_norm_g, w_in, q_lat_g, kv_lat_g, w_uq, w_ukv,
              q_norm_g, k_norm_g, conv_w, conv_b, conv_ln_g, conv_ln_b, w_out, ffn_w_gate, ffn_w_up, ffn_w_down,
              router_w, moe_w_gate, moe_w_up, moe_w_down):
    rows = x.shape[1] // GRID_W
    rope = _axial_rope(rows)
    for l in range(DEPTH):
        last = l == DEPTH - 1
        sx = _modulation(c, ada_w[l], ada_b[l])
        sc = _modulation(c_ctx[None, :], ada_w[l], ada_b[l])

        hc = _adaln(ctx, mix_norm_g[l], sc[0], sc[1])
        if last:
            kv_cols = hc @ w_in[l][:, OFF_CKV:OFF_CONV]
            k_c, v_c = _mla_keys_values(kv_cols[..., :KV_LORA], kv_cols[..., KV_LORA:],
                                        w_ukv[l], kv_lat_g[l], k_norm_g[l], None)
        else:
            cols_c = hc @ w_in[l]
            k_c, v_c = _mla_keys_values(cols_c[..., OFF_CKV:OFF_KR], cols_c[..., OFF_KR:OFF_CONV],
                                        w_ukv[l], kv_lat_g[l], k_norm_g[l], None)
            mix_c = _mixer_out(cols_c, k_c, v_c, None, w_uq[l], q_lat_g[l], q_norm_g[l],
                               conv_w[l], conv_b[l], conv_ln_g[l], conv_ln_b[l], w_out[l])
            ctx_next = ctx + sc[2] * mix_c
            ctx_next = ctx_next + sc[5] * _channel_mixer(
                _adaln(ctx_next, ffn_norm_g[l], sc[3], sc[4]), l,
                ffn_w_gate, ffn_w_up, ffn_w_down, router_w, moe_w_gate, moe_w_up, moe_w_down)

        hx = _adaln(x, mix_norm_g[l], sx[0], sx[1])
        cols_x = hx @ w_in[l]
        k_x, v_x = _mla_keys_values(cols_x[..., OFF_CKV:OFF_KR], cols_x[..., OFF_KR:OFF_CONV],
                                    w_ukv[l], kv_lat_g[l], k_norm_g[l], rope)
        k_all = jnp.concatenate([k_x, k_c], axis=1)
        v_all = jnp.concatenate([v_x, v_c], axis=1)
        mix_x = _mixer_out(cols_x, k_all, v_all, rope, w_uq[l], q_lat_g[l], q_norm_g[l],
                           conv_w[l], conv_b[l], conv_ln_g[l], conv_ln_b[l], w_out[l])
        x = x + sx[2] * mix_x
        x = x + sx[5] * _channel_mixer(
            _adaln(x, ffn_norm_g[l], sx[3], sx[4]), l,
            ffn_w_gate, ffn_w_up, ffn_w_down, router_w, moe_w_gate, moe_w_up, moe_w_down)

        if not last:
            ctx = ctx_next
    return x
```

```cpp
#include <hip/hip_runtime.h>
#include <cstdio>
#include <cstdint>

#ifndef MK_PER_PHASE
#define MK_PER_PHASE 0
#endif

#define GAS __attribute__((address_space(1)))
#define LAS __attribute__((address_space(3)))
typedef unsigned short bf16;
typedef short bf16x8 __attribute__((ext_vector_type(8)));
typedef short s16x4 __attribute__((ext_vector_type(4)));
typedef float f32x4 __attribute__((ext_vector_type(4)));
typedef float f32x2 __attribute__((ext_vector_type(2)));
typedef float f32x16 __attribute__((ext_vector_type(16)));
typedef unsigned u32x4 __attribute__((ext_vector_type(4)));
typedef unsigned u32x2 __attribute__((ext_vector_type(2)));
typedef GAS unsigned gu32;

constexpr int DM = 1024, NB = 8, SEQ = 2048, CTXL = 256, NH = 8, QKN = 64, QKR = 32, QKH = 96, VH = 64;
constexpr int QL = 384, KVL = 256, CCH = 256, CWID = 31, FCH = 256, INC = 1440, DFF = 2816, NE = 8;
constexpr int RX = NB * SEQ, RC = NB * CTXL, RT = RX + RC;
constexpr int OFF_CKV = 384, OFF_KR = 640, OFF_CONV = 672, OFF_FOUR = 1184;
constexpr int NCOL = 1280;
constexpr int NC3 = 768;
constexpr int C_KR = 384, C_CKV = 512;
constexpr float EPS = 1e-6f;
constexpr int NSLOT = RX + NE * 256;
constexpr int N_PHASES = 25;

constexpr size_t MiB = 1u << 20;
constexpr size_t WS_CTL = 0, CTL_ZERO_BYTES = 1 * MiB;
constexpr size_t WS_MOD = 1 * MiB;
constexpr size_t WS_ROPE = 2 * MiB;
constexpr size_t WS_MOE = 3 * MiB;
constexpr size_t WS_DFTC = 5 * MiB;
constexpr size_t WS_WUQ = 6 * MiB;
constexpr size_t WS_WUKV = 8 * MiB;
constexpr size_t WS_WIN = 10 * MiB;
constexpr size_t WS_WFT = 15 * MiB;
constexpr size_t WS_WOUT = 17 * MiB;
constexpr size_t WS_WGU = 21 * MiB;
constexpr size_t WS_WD = 32 * MiB;
constexpr size_t WS_SSQP = 38 * MiB;
constexpr size_t WS_MOEGU = 54 * MiB;
constexpr size_t WS_MOED = 142 * MiB;
constexpr size_t WS_CTXS = 186 * MiB;
constexpr size_t WS_DYN = 194 * MiB;
constexpr size_t DY_C = WS_DYN;
constexpr size_t DY_Z = DY_C + 45 * MiB;
constexpr size_t DY_Q = DY_Z + 18 * MiB;
constexpr size_t DY_KV = DY_Q + 27 * MiB;
constexpr size_t DY_M = DY_KV + 36 * MiB;
constexpr size_t DY_H = DY_M + 36 * MiB;
constexpr size_t WS_END = DY_H + 36 * MiB;
constexpr size_t DY_ACT = DY_C;
constexpr size_t DY_Y = DY_C + 27 * MiB, DY_K = DY_H;
static_assert(DY_ACT + (size_t)RT * DFF * 2 <= DY_M, "act overlay");
constexpr size_t MO_CNT = 0;
constexpr size_t MO_META = 64 * 1024;
constexpr size_t MO_TOKE = 128 * 1024;
constexpr size_t MO_TOKW = 256 * 1024;
constexpr size_t MO_SROW = 512 * 1024;
constexpr size_t MO_SW = 768 * 1024;

constexpr int CW_TMO = 0, CW_BAR = 4096;

constexpr int RING_BYTES = 131072;
constexpr int LDSCTL_OFF = RING_BYTES, MISC_OFF = LDSCTL_OFF + 320;
constexpr int LDS_BYTES = 147456;

#define RLX_AGENT __ATOMIC_RELAXED, __HIP_MEMORY_SCOPE_AGENT
#define LDS_WAIT() asm volatile("s_waitcnt lgkmcnt(0)" ::: "memory")
#define VM_WAIT() asm volatile("s_waitcnt vmcnt(0)" ::: "memory")
__device__ __forceinline__ unsigned f2bf(float f) { unsigned u = __builtin_bit_cast(unsigned, f); return (u + 0x7fffu + ((u >> 16) & 1u)) >> 16; }
__device__ __forceinline__ unsigned pk2(float lo, float hi) { return f2bf(lo) | (f2bf(hi) << 16); }
__device__ __forceinline__ float bflo(unsigned w) { return __builtin_bit_cast(float, w << 16); }
__device__ __forceinline__ float bfhi(unsigned w) { return __builtin_bit_cast(float, w & 0xffff0000u); }
__device__ __forceinline__ float bf1(bf16 v) { return __builtin_bit_cast(float, (unsigned)v << 16); }
__device__ __forceinline__ unsigned cvt_pk_bf16(float lo, float hi) { unsigned r; asm volatile("v_cvt_pk_bf16_f32 %0, %1, %2" : "=v"(r) : "v"(lo), "v"(hi)); return r; }
template <int CTRL> __device__ __forceinline__ float dpp_f(float v) { return __builtin_bit_cast(float, __builtin_amdgcn_update_dpp(0, __builtin_bit_cast(int, v), CTRL, 0xf, 0xf, true)); }
__device__ __forceinline__ float sum8(float v) {
    v += dpp_f<0xB1>(v);
    v += dpp_f<0x4E>(v);
    v += dpp_f<0x141>(v);
    return v;
}
__device__ __forceinline__ float wave_sum(float v) {
    v = sum8(v);
    v += dpp_f<0x140>(v);
    { auto r = __builtin_amdgcn_permlane16_swap(__float_as_uint(v), __float_as_uint(v), false, false); v = __uint_as_float(r[0]) + __uint_as_float(r[1]); }
    { auto r = __builtin_amdgcn_permlane32_swap(__float_as_uint(v), __float_as_uint(v), false, false); v = __uint_as_float(r[0]) + __uint_as_float(r[1]); }
    return v;
}
template <int CTRL> __device__ __forceinline__ int dpp_i(int v) { return __builtin_amdgcn_update_dpp(0, v, CTRL, 0xf, 0xf, true); }
__device__ __forceinline__ int wave_isum(int v) {
    v += dpp_i<0xB1>(v); v += dpp_i<0x4E>(v); v += dpp_i<0x141>(v); v += dpp_i<0x140>(v);
    { auto r = __builtin_amdgcn_permlane16_swap((unsigned)v, (unsigned)v, false, false); v = (int)(r[0] + r[1]); }
    { auto r = __builtin_amdgcn_permlane32_swap((unsigned)v, (unsigned)v, false, false); v = (int)(r[0] + r[1]); }
    return v;
}
__device__ __forceinline__ float sigmoidf_(float x) { return 1.0f / (1.0f + __expf(-x)); }
__device__ __forceinline__ float siluf_(float x) { return x / (1.0f + __expf(-x)); }

__device__ __forceinline__ int lane_id() { int l; asm volatile("v_mbcnt_lo_u32_b32 %0, -1, 0\n\tv_mbcnt_hi_u32_b32 %0, -1, %0" : "=v"(l)); return l; }
#define XB_TMO      128
#define XB_XCNT(j)  (256  + 64 * (j))
#define XB_XSUB(j)  (1280 + 64 * (j))
#define XB_XGEN(j)  (2304 + 64 * (j))
#define XB_TOP      3328
#define XB_TOPGEN   3392
#define XCD_BAR_WORDS 3456
#define XB_SPIN_CAP (1u << 18)
__device__ __forceinline__ unsigned xb_ld(unsigned* p)              { return __hip_atomic_load(p, __ATOMIC_RELAXED, __HIP_MEMORY_SCOPE_AGENT); }
__device__ __forceinline__ unsigned xb_add(unsigned* p, unsigned v) { return __hip_atomic_fetch_add(p, v, __ATOMIC_RELAXED, __HIP_MEMORY_SCOPE_AGENT); }
__device__ __forceinline__ unsigned xb_xcc_id() { return (unsigned)__builtin_amdgcn_s_getreg((3 << 11) | 20) & 0xFu; }
#define XB_SPIN(cond, bar) do { unsigned _sp = 0; while (cond) { __builtin_amdgcn_s_sleep(1); \
    if ((++_sp & 255u) == 0u) { if (xb_ld(&(bar)[XB_TMO])) break; if (_sp > XB_SPIN_CAP) { atomicAdd(&(bar)[XB_TMO], 1u); break; } } } } while (0)
struct XcdBarrier { unsigned* bar; unsigned x; volatile LAS unsigned* st; int wave; };
__device__ __forceinline__ XcdBarrier xcd_barrier_post(unsigned* bar, volatile LAS unsigned* st, int wave) {
    XcdBarrier b; b.bar = bar; b.x = xb_xcc_id(); b.st = st; b.wave = wave;
    if (wave == 0 && lane_id() == 0) (void)xb_add(&bar[XB_XCNT(b.x)], 1u);
    return b;
}
__device__ __forceinline__ void xcd_barrier_complete(unsigned* bar, unsigned x, unsigned& nloc, unsigned& nx) {
    const unsigned G = gridDim.x * gridDim.y * gridDim.z;
    unsigned sum, cnt, mine, sp = 0u;
    for (;;) {
        sum = 0u; cnt = 0u; mine = 0u;
#pragma nounroll
        for (unsigned j = 0; j < 16; ++j) { const unsigned c = xb_ld(&bar[XB_XCNT(j)]); sum += c; cnt += (c > 0u) ? 1u : 0u; mine = (j == x) ? c : mine; }
        if (sum == G) break;
        __builtin_amdgcn_s_sleep(1);
        if ((++sp & 255u) == 0u) { if (xb_ld(&bar[XB_TMO])) break; if (sp > XB_SPIN_CAP) { atomicAdd(&bar[XB_TMO], 1u); break; } }
    }
    nloc = mine > 0u ? mine : 1u; nx = cnt > 0u ? cnt : 1u;
}
__device__ __forceinline__ void xcd_barrier(const XcdBarrier& b) {
    asm volatile("s_waitcnt vmcnt(0)" ::: "memory");
    __syncthreads();
    if (b.wave == 0 && lane_id() == 0) {
        unsigned* bar = b.bar;
        __builtin_amdgcn_s_waitcnt(0);
        unsigned nloc = b.st[0], nx = b.st[1];
        if (nloc == 0u) { xcd_barrier_complete(bar, b.x, nloc, nx); b.st[0] = nloc; b.st[1] = nx; }
        const unsigned old = xb_add(&bar[XB_XSUB(b.x)], 1u);
        const unsigned gen = old / nloc;
        if (old + 1u == (gen + 1u) * nloc) {
            __builtin_amdgcn_fence(__ATOMIC_RELEASE, "agent");
            asm volatile("s_waitcnt vmcnt(0)" ::: "memory");
            const unsigned og = xb_add(&bar[XB_TOP], 1u);
            const unsigned tg = og / nx;
            if (og + 1u == (tg + 1u) * nx) xb_add(&bar[XB_TOPGEN], 1u);
            else XB_SPIN(xb_ld(&bar[XB_TOPGEN]) == tg, bar);
            __builtin_amdgcn_fence(__ATOMIC_ACQUIRE, "agent");
            xb_add(&bar[XB_XGEN(b.x)], 1u);
            asm volatile("s_waitcnt vmcnt(0)" ::: "memory");
        } else {
            XB_SPIN(xb_ld(&bar[XB_XGEN(b.x)]) == gen, bar);
            __builtin_amdgcn_fence(__ATOMIC_ACQUIRE, "agent");
            asm volatile("s_waitcnt vmcnt(0)" ::: "memory");
        }
    }
    __syncthreads();
}

namespace pg8 {
constexpr int BM = 256, BK = 64, HALF = 128, HTB = HALF * BK * 2, STAGE_BYTES = 8 * HTB;
__host__ __device__ __forceinline__ int lds_byte(int r, int c) { const int st = (r >> 4) * 2 + (c >> 5), rr = r & 15, cc = c & 31, ob = rr * 64 + cc * 2; return st * 1024 + (ob ^ (((ob >> 9) & 1) << 5)); }
__host__ __device__ __forceinline__ void stage_rc(int b, int& R, int& C) { const int st = b / 1024, sb = b % 1024, swz = sb ^ (((sb >> 9) & 1) << 5); R = (st >> 1) * 16 + swz / 64; C = (st & 1) * 32 + (swz % 64) / 2; }
__host__ __device__ __forceinline__ int perm32(int rho) { const int n = rho >> 4, i = rho & 15; return 8 * (i >> 2) + 4 * n + (i & 3); }

struct Unit { int pm, pn; };
struct GemmK { int lda, ldb, K; };

__device__ __forceinline__ void store_tile_bf16(const f32x4 (&acc)[2][2][4][2], bf16* C, int ldc, int wr, int wc, int fr, int fq) {
    const unsigned off0 = (unsigned)((wr * 64 + fr) * ldc + wc * 32 + 8 * fq) * 2u;
#pragma unroll
    for (int ai = 0; ai < 2; ++ai)
#pragma unroll
        for (int m = 0; m < 4; ++m) { const unsigned offr = off0 + (unsigned)((ai * HALF + m * 16) * ldc) * 2u;
#pragma unroll
            for (int bj = 0; bj < 2; ++bj) { const f32x4 v0 = acc[ai][bj][m][0], v1 = acc[ai][bj][m][1];
                u32x4 w; w.x = cvt_pk_bf16(v0[0], v0[1]); w.y = cvt_pk_bf16(v0[2], v0[3]); w.z = cvt_pk_bf16(v1[0], v1[1]); w.w = cvt_pk_bf16(v1[2], v1[3]);
                *(u32x4*)((char*)C + (offr + (unsigned)(bj * HALF * 2))) = w; } }
}
__device__ __forceinline__ void store_tile_swiglu(const f32x4 (&acc)[2][2][4][2], bf16* C, int ldc, int wr, int wc, int fr, int fq) {
    const unsigned off0 = (unsigned)((wr * 64 + fr) * ldc + wc * 32 + 8 * fq) * 2u;
#pragma unroll
    for (int ai = 0; ai < 2; ++ai)
#pragma unroll
        for (int m = 0; m < 4; ++m) { const unsigned offr = off0 + (unsigned)((ai * HALF + m * 16) * ldc) * 2u;
            float o[8];
#pragma unroll
            for (int n = 0; n < 2; ++n)
#pragma unroll
                for (int e = 0; e < 4; ++e) { const float g = acc[ai][0][m][n][e], up = acc[ai][1][m][n][e]; o[n * 4 + e] = g * __builtin_amdgcn_rcpf(1.0f + __expf(-g)) * up; }
            u32x4 w; w.x = cvt_pk_bf16(o[0], o[1]); w.y = cvt_pk_bf16(o[2], o[3]); w.z = cvt_pk_bf16(o[4], o[5]); w.w = cvt_pk_bf16(o[6], o[7]);
            *(u32x4*)((char*)C + offr) = w; }
}
__device__ __forceinline__ void store_tile_resid(const f32x4 (&acc)[2][2][4][2], const float* X, float* C, const float* gvp, int wr, int wc, int fr, int fq) {
    const int col0 = wc * 32 + 4 * fq;
    f32x4 gv[2][2];
#pragma unroll
    for (int bj = 0; bj < 2; ++bj)
#pragma unroll
        for (int n = 0; n < 2; ++n) gv[bj][n] = *(const f32x4*)((const char*)gvp + (unsigned)(col0 + bj * HALF + n * 16) * 4u);
    const unsigned off0 = (unsigned)((wr * 64 + fr) * DM + col0) * 4u;
#pragma unroll
    for (int ai = 0; ai < 2; ++ai)
#pragma unroll
        for (int m = 0; m < 4; ++m) { const unsigned offr = off0 + (unsigned)((ai * HALF + m * 16) * DM) * 4u;
#pragma unroll
            for (int bj = 0; bj < 2; ++bj)
#pragma unroll
                for (int n = 0; n < 2; ++n) { const unsigned o = offr + (unsigned)(bj * HALF + n * 16) * 4u; const f32x4 xv = *(const f32x4*)((const char*)X + o); *(f32x4*)((char*)C + o) = xv + gv[bj][n] * acc[ai][bj][m][n]; } }
}

template <int NP>
__device__ __forceinline__ void store_tile_bf16_rs(const f32x4 (&acc)[2][2][4][2], bf16* C, int ldc, const float* part, float inv_k, int wr, int wc, int fr, int fq) {
    const unsigned off0 = (unsigned)((wr * 64 + fr) * ldc + wc * 32 + 8 * fq) * 2u;
#pragma unroll
    for (int ai = 0; ai < 2; ++ai)
#pragma unroll
        for (int m = 0; m < 4; ++m) { const unsigned offr = off0 + (unsigned)((ai * HALF + m * 16) * ldc) * 2u;
            const float* pr = part + (size_t)(ai * HALF + wr * 64 + m * 16 + fr) * 12; float ss;
            { const f32x4 p0 = *(const f32x4*)pr; ss = (p0.x + p0.y) + (p0.z + p0.w); if (NP == 8) { const f32x4 p1 = *(const f32x4*)(pr + 4); ss += (p1.x + p1.y) + (p1.z + p1.w); } }
            const float rs = 1.0f / sqrtf(ss * inv_k + EPS);
#pragma unroll
            for (int bj = 0; bj < 2; ++bj) { const f32x4 v0 = acc[ai][bj][m][0] * rs, v1 = acc[ai][bj][m][1] * rs;
                u32x4 w; w.x = cvt_pk_bf16(v0[0], v0[1]); w.y = cvt_pk_bf16(v0[2], v0[3]); w.z = cvt_pk_bf16(v1[0], v1[1]); w.w = cvt_pk_bf16(v1[2], v1[3]);
                *(u32x4*)((char*)C + (offr + (unsigned)(bj * HALF * 2))) = w; } }
}
template <int NBJ>
__device__ __forceinline__ void store_tile_bf16_ssq(const f32x4 (&acc)[2][2][4][2], bf16* C, int ldc, float* part, int wr, int wc, int fr, int fq) {
    const unsigned off0 = (unsigned)((wr * 64 + fr) * ldc + wc * 32 + 8 * fq) * 2u;
#pragma unroll
    for (int ai = 0; ai < 2; ++ai)
#pragma unroll
        for (int m = 0; m < 4; ++m) { const unsigned offr = off0 + (unsigned)((ai * HALF + m * 16) * ldc) * 2u; float sq = 0.f;
#pragma unroll
            for (int bj = 0; bj < 2; ++bj) { const f32x4 v0 = acc[ai][bj][m][0], v1 = acc[ai][bj][m][1];
                u32x4 w; w.x = cvt_pk_bf16(v0[0], v0[1]); w.y = cvt_pk_bf16(v0[2], v0[3]); w.z = cvt_pk_bf16(v1[0], v1[1]); w.w = cvt_pk_bf16(v1[2], v1[3]);
                *(u32x4*)((char*)C + (offr + (unsigned)(bj * HALF * 2))) = w;
                if (bj < NBJ) { float a;
                    a = bflo(w.x); sq += a * a; a = bfhi(w.x); sq += a * a; a = bflo(w.y); sq += a * a; a = bfhi(w.y); sq += a * a;
                    a = bflo(w.z); sq += a * a; a = bfhi(w.z); sq += a * a; a = bflo(w.w); sq += a * a; a = bfhi(w.w); sq += a * a; } }
            { auto r = __builtin_amdgcn_permlane16_swap(__float_as_uint(sq), __float_as_uint(sq), false, false); sq = __uint_as_float(r[0]) + __uint_as_float(r[1]); }
            { auto r = __builtin_amdgcn_permlane32_swap(__float_as_uint(sq), __float_as_uint(sq), false, false); sq = __uint_as_float(r[0]) + __uint_as_float(r[1]); }
            if (fq == 0) part[(size_t)(ai * HALF + wr * 64 + m * 16 + fr) * 12] = sq; }
}
__device__ __forceinline__ void store_tile_glu(const f32x4 (&acc)[2][2][4][2], bf16* C, int ldc, int wr, int wc, int fr, int fq) {
    const unsigned off0 = (unsigned)((wr * 64 + fr) * ldc + wc * 32 + 8 * fq) * 2u;
#pragma unroll
    for (int ai = 0; ai < 2; ++ai)
#pragma unroll
        for (int m = 0; m < 4; ++m) { const unsigned offr = off0 + (unsigned)((ai * HALF + m * 16) * ldc) * 2u;
            float o[8];
#pragma unroll
            for (int n = 0; n < 2; ++n)
#pragma unroll
                for (int e = 0; e < 4; ++e) { const float av = acc[ai][0][m][n][e], g = acc[ai][1][m][n][e]; o[n * 4 + e] = av * __builtin_amdgcn_rcpf(1.0f + __expf(-g)); }
            u32x4 w; w.x = cvt_pk_bf16(o[0], o[1]); w.y = cvt_pk_bf16(o[2], o[3]); w.z = cvt_pk_bf16(o[4], o[5]); w.w = cvt_pk_bf16(o[6], o[7]);
            *(u32x4*)((char*)C + offr) = w; }
}

template <class Epi, class Sched>
__device__ __forceinline__ void gemm_phase(LAS unsigned char* lds, const int wave, const GemmK g, const Sched& S, const Epi& E) {
    int tid = wave * 64 + lane_id(); asm volatile("" : "+v"(tid));
    const int wid = wave, lane = tid & 63, wr = wid >> 2, wc = wid & 3, fr = lane & 15, fq = lane >> 4;
    const int nt = g.K / BK;
    unsigned voffA[2], voffB[2];
#pragma unroll
    for (int i = 0; i < 2; ++i) { int R, C; stage_rc(tid * 16 + i * 8192, R, C); const int Rb = Epi::PERM ? ((R & ~31) + perm32(R & 31)) : R;
        voffA[i] = (unsigned)(R * g.lda + C) * 2u; voffB[i] = (unsigned)(Rb * g.ldb + C) * 2u; }
    const size_t kstep = (size_t)(BK * 2);
    const size_t hsA = (size_t)HALF * g.lda * 2, hsB = (size_t)HALF * g.ldb * 2;
    const unsigned ldsw = (unsigned)wid * 1024u;
    const int aoff = lds_byte(wr * 64 + fr, fq * 8), boff = lds_byte(wc * 32 + fr, fq * 8);
#define PG8_SA(b, h) (((b) * 2 + (h)) * HTB)
#define PG8_SB(b, h) ((4 + (b) * 2 + (h)) * HTB)
#define PG8_STAGE(bufoff, gbase, voff) do { _Pragma("unroll") for (int _i = 0; _i < 2; ++_i) \
        __builtin_amdgcn_global_load_lds((const unsigned*)((const char*)(gbase) + (voff)[_i]), (LAS unsigned*)(lds + (bufoff) + ldsw + _i * 8192), 16, 0, 0); } while (0)
#define PG8_LDA(dst, b, h) do { _Pragma("unroll") for (int m = 0; m < 4; ++m) _Pragma("unroll") for (int k = 0; k < 2; ++k) dst[m][k] = *(const LAS bf16x8*)(lds + PG8_SA(b, h) + aoff + m * 2048 + k * 1024); } while (0)
#define PG8_LDB(dst, b, h) do { _Pragma("unroll") for (int n = 0; n < 2; ++n) _Pragma("unroll") for (int k = 0; k < 2; ++k) dst[n][k] = *(const LAS bf16x8*)(lds + PG8_SB(b, h) + boff + n * 2048 + k * 1024); } while (0)
#define PG8_MMA(ai, bj, At, Bt) do { __builtin_amdgcn_s_setprio(1); _Pragma("unroll") for (int m = 0; m < 4; ++m) _Pragma("unroll") for (int n = 0; n < 2; ++n) _Pragma("unroll") for (int k = 0; k < 2; ++k) \
        acc[ai][bj][m][n] = __builtin_amdgcn_mfma_f32_16x16x32_bf16(Bt[n][k], At[m][k], acc[ai][bj][m][n], 0, 0, 0); __builtin_amdgcn_s_setprio(0); } while (0)
#define PG8_WAIT_V(n) asm volatile("s_waitcnt vmcnt(" #n ")" ::: "memory")
#define PG8_WAIT_L(n) asm volatile("s_waitcnt lgkmcnt(" #n ")" ::: "memory")
#define PG8_BAR __builtin_amdgcn_s_barrier()
#define PG8_SCHED __builtin_amdgcn_sched_barrier(0)
    Unit cur, nxt; int ui = 0;
    if (!S.next(0, cur)) return;
    f32x4 acc[2][2][4][2];
#pragma unroll
    for (int a = 0; a < 2; ++a)
#pragma unroll
        for (int b = 0; b < 2; ++b)
#pragma unroll
            for (int m = 0; m < 4; ++m)
#pragma unroll
                for (int n = 0; n < 2; ++n) acc[a][b][m][n] = (f32x4){0.f, 0.f, 0.f, 0.f};
    bf16x8 At[4][2], B0[2][2], B1[2][2];
    const char* cA = S.aptr(cur); const char* cB = S.bptr(cur);
    PG8_STAGE(PG8_SB(0, 0), cB, voffB); PG8_STAGE(PG8_SB(0, 1), cB + hsB, voffB); PG8_STAGE(PG8_SA(0, 0), cA, voffA); PG8_STAGE(PG8_SA(0, 1), cA + hsA, voffA);
    if (wr == 1) PG8_BAR;
    PG8_WAIT_V(2); PG8_BAR;
    PG8_STAGE(PG8_SB(1, 0), cB + kstep, voffB); PG8_STAGE(PG8_SA(1, 0), cA + kstep, voffA); PG8_STAGE(PG8_SB(1, 1), cB + hsB + kstep, voffB);
    PG8_WAIT_V(6); PG8_BAR;
    for (;;) {
        const bool has_next = S.next(ui + 1, nxt);
        const char* nA = has_next ? S.aptr(nxt) : cA; const char* nB = has_next ? S.bptr(nxt) : cB;
#pragma nounroll
        for (int t = 0; t < nt; t += 2) {
            const bool last = (t == nt - 2);
            const char* a1 = cA + (size_t)(t + 1) * kstep;
            const char* a2 = last ? nA : cA + (size_t)(t + 2) * kstep; const char* b2 = last ? nB : cB + (size_t)(t + 2) * kstep;
            const char* a3 = a2 + kstep; const char* b3 = b2 + kstep;
            PG8_LDB(B0, 0, 0); PG8_LDB(B1, 0, 1); PG8_SCHED; PG8_LDA(At, 0, 0); PG8_STAGE(PG8_SA(1, 1), a1 + hsA, voffA);
            PG8_WAIT_V(8); PG8_WAIT_L(0); PG8_BAR; PG8_MMA(0, 0, At, B0); PG8_MMA(0, 1, At, B1); PG8_BAR; PG8_SCHED;
            PG8_LDA(At, 0, 1); PG8_STAGE(PG8_SB(0, 0), b2, voffB); PG8_STAGE(PG8_SB(0, 1), b2 + hsB, voffB); PG8_STAGE(PG8_SA(0, 0), a2, voffA);
            PG8_WAIT_V(8); PG8_WAIT_L(0); PG8_BAR; PG8_MMA(1, 0, At, B0); PG8_MMA(1, 1, At, B1); PG8_BAR; PG8_SCHED;
            PG8_LDB(B0, 1, 0); PG8_LDB(B1, 1, 1); PG8_SCHED; PG8_LDA(At, 1, 0); PG8_STAGE(PG8_SA(0, 1), a2 + hsA, voffA);
            PG8_WAIT_V(8); PG8_WAIT_L(0); PG8_BAR; PG8_MMA(0, 0, At, B0); PG8_MMA(0, 1, At, B1); PG8_BAR; PG8_SCHED;
            PG8_LDA(At, 1, 1); PG8_STAGE(PG8_SB(1, 0), b3, voffB); PG8_STAGE(PG8_SB(1, 1), b3 + hsB, voffB); PG8_STAGE(PG8_SA(1, 0), a3, voffA);
            PG8_WAIT_V(8); PG8_WAIT_L(0); PG8_BAR; PG8_MMA(1, 0, At, B0); PG8_MMA(1, 1, At, B1); PG8_BAR; PG8_SCHED;
        }
        if (wr == 0) PG8_BAR;
        { int fr_ = fr, fq_ = fq; asm volatile("" : "+v"(fr_), "+v"(fq_));
          E(acc, cur, wr, wc, fr_, fq_); }
        if (!has_next) break;
#pragma unroll
        for (int a = 0; a < 2; ++a)
#pragma unroll
            for (int b = 0; b < 2; ++b)
#pragma unroll
                for (int m = 0; m < 4; ++m)
#pragma unroll
                    for (int n = 0; n < 2; ++n) acc[a][b][m][n] = (f32x4){0.f, 0.f, 0.f, 0.f};
        cur = nxt; cA = nA; cB = nB; ++ui;
        if (wr == 1) PG8_BAR;
    }
    PG8_WAIT_V(0);
    PG8_BAR;
#undef PG8_SA
#undef PG8_SB
#undef PG8_STAGE
#undef PG8_LDA
#undef PG8_LDB
#undef PG8_MMA
#undef PG8_WAIT_V
#undef PG8_WAIT_L
#undef PG8_BAR
#undef PG8_SCHED
}
}

namespace att {
constexpr int SHM_V = 64 * 64 * 2, SHM_K = 64 * 256;
constexpr int NSLOT = 3;
constexpr int LDS_V = 0, LDS_K = NSLOT * SHM_V, LDS_WS = NSLOT * SHM_V + NSLOT * SHM_K, LDS_TOTAL = LDS_WS + 8 * 64 * 4;
constexpr float THR2 = 11.5f;
#define KSWZ(row, colB) ((row) * 256 + ((colB) ^ (((row) & 7) << 4)))
#define SBAR() __builtin_amdgcn_sched_barrier(0)
__device__ __forceinline__ int crow(int r, int hi) { return (r & 3) + 8 * (r >> 2) + 4 * hi; }
__device__ __forceinline__ int v_st(int k, int c) { const int kk = (k & ~0xC) | ((k & 4) << 1) | ((k & 8) >> 1); return ((kk >> 3) * 2 + (c >> 5)) * 512 + ((kk & 7) * 32 + (c & 31)) * 2; }
__device__ __forceinline__ int v_rd_base(int lane) { return ((lane & 3) << 3) | (((lane >> 2) & 3) << 6) | (((lane >> 4) & 1) << 5) | (((lane >> 5) & 1) << 8); }
constexpr int v_rd_off(int d0, int ks, int half) { return d0 * 512 + ks * 2048 + half * 1024; }
template <int OFF> __device__ __forceinline__ s16x4 tr_read(int vb) {
    s16x4 r; asm volatile("ds_read_b64_tr_b16 %0, %1 offset:%2" : "=&v"(r) : "v"(vb), "i"(OFF) : "memory"); return r;
}
__device__ __forceinline__ void partialSM(f32x16& p0, f32x16& p1, float& m_reg, float& mn, float& alpha, const bool fixed) {
    if (!fixed) {
        float pmax = p0[0];
#pragma unroll
        for (int r = 1; r < 16; ++r) pmax = fmaxf(pmax, p0[r]);
#pragma unroll
        for (int r = 0; r < 16; ++r) pmax = fmaxf(pmax, p1[r]);
        { auto rr = __builtin_amdgcn_permlane32_swap(__float_as_uint(pmax), __float_as_uint(pmax), false, false);
          pmax = fmaxf(__uint_as_float(rr[0]), __uint_as_float(rr[1])); }
        if (__builtin_expect(__all(pmax - m_reg <= THR2), 1)) { mn = m_reg; alpha = 1.f; }
        else { mn = fmaxf(m_reg, pmax); alpha = __builtin_amdgcn_exp2f(m_reg - mn); m_reg = mn; }
#pragma unroll
        for (int r = 0; r < 16; ++r) p0[r] = p0[r] - mn;
#pragma unroll
        for (int r = 0; r < 16; ++r) p1[r] = p1[r] - mn;
    } else { mn = 0.f; alpha = 1.f; }
#pragma unroll
    for (int r = 0; r < 16; ++r) p0[r] = __builtin_amdgcn_exp2f(p0[r]);
}
__device__ __forceinline__ void finishSM(f32x16& p0, f32x16& p1, float alpha, float& l_reg, bf16x8& pa0, bf16x8& pa1, bf16x8& pa2, bf16x8& pa3) {
#pragma unroll
    for (int r = 0; r < 16; ++r) p1[r] = __builtin_amdgcn_exp2f(p1[r]);
    float ps = 0;
#pragma unroll
    for (int r = 0; r < 16; ++r) ps += p0[r];
#pragma unroll
    for (int r = 0; r < 16; ++r) ps += p1[r];
    { auto rr = __builtin_amdgcn_permlane32_swap(__float_as_uint(ps), __float_as_uint(ps), false, false);
      ps = __uint_as_float(rr[0]) + __uint_as_float(rr[1]); }
    l_reg = l_reg * alpha + ps;
#define PK4(P, BASE, OUT) do { unsigned a0 = cvt_pk_bf16(P[BASE + 0], P[BASE + 1]), a1 = cvt_pk_bf16(P[BASE + 2], P[BASE + 3]);   \
    unsigned b0 = cvt_pk_bf16(P[BASE + 4], P[BASE + 5]), b1 = cvt_pk_bf16(P[BASE + 6], P[BASE + 7]);                              \
    auto r0 = __builtin_amdgcn_permlane32_swap(a0, b0, false, false); auto r1 = __builtin_amdgcn_permlane32_swap(a1, b1, false, false); \
    u32x4 w = {r0[0], r1[0], r0[1], r1[1]}; OUT = __builtin_bit_cast(bf16x8, w); } while (0)
    PK4(p0, 0, pa0); PK4(p0, 8, pa1); PK4(p1, 0, pa2); PK4(p1, 8, pa3);
#undef PK4
}
__device__ __forceinline__ void qkt(f32x16& p0, f32x16& p1, const LAS char* Ks, const bf16x8* qr, int r32, int hi, const float c0) {
#pragma unroll
    for (int r = 0; r < 16; ++r) { p0[r] = c0; p1[r] = c0; }
#pragma unroll
    for (int d0 = 0; d0 < 6; ++d0) { const int cb = (d0 * 16 + hi * 8) * 2;
        const bf16x8 b0 = *(const LAS bf16x8*)(Ks + KSWZ(r32, cb));
        const bf16x8 b1 = *(const LAS bf16x8*)(Ks + KSWZ(32 + r32, cb));
        p0 = __builtin_amdgcn_mfma_f32_32x32x16_bf16(b0, qr[d0], p0, 0, 0, 0);
        p1 = __builtin_amdgcn_mfma_f32_32x32x16_bf16(b1, qr[d0], p1, 0, 0, 0); }
}
template <int D0> __device__ __forceinline__ void pv_one(f32x16& od, int vb, bf16x8 pa0, bf16x8 pa1, bf16x8 pa2, bf16x8 pa3) {
    const s16x4 l0 = tr_read<v_rd_off(D0, 0, 0)>(vb), h0 = tr_read<v_rd_off(D0, 0, 1)>(vb), l1 = tr_read<v_rd_off(D0, 1, 0)>(vb), h1 = tr_read<v_rd_off(D0, 1, 1)>(vb);
    const s16x4 l2 = tr_read<v_rd_off(D0, 2, 0)>(vb), h2 = tr_read<v_rd_off(D0, 2, 1)>(vb), l3 = tr_read<v_rd_off(D0, 3, 0)>(vb), h3 = tr_read<v_rd_off(D0, 3, 1)>(vb);
    asm volatile("s_waitcnt lgkmcnt(0)" ::: "memory"); SBAR();
#define PKV(L, H) (bf16x8){L[0], L[1], L[2], L[3], H[0], H[1], H[2], H[3]}
    od = __builtin_amdgcn_mfma_f32_32x32x16_bf16(pa0, PKV(l0, h0), od, 0, 0, 0);
    od = __builtin_amdgcn_mfma_f32_32x32x16_bf16(pa1, PKV(l1, h1), od, 0, 0, 0);
    od = __builtin_amdgcn_mfma_f32_32x32x16_bf16(pa2, PKV(l2, h2), od, 0, 0, 0);
    od = __builtin_amdgcn_mfma_f32_32x32x16_bf16(pa3, PKV(l3, h3), od, 0, 0, 0);
#undef PKV
}
__device__ __forceinline__ void pv_all(f32x16* o, int vb, bf16x8 pa0, bf16x8 pa1, bf16x8 pa2, bf16x8 pa3) {
    pv_one<0>(o[0], vb, pa0, pa1, pa2, pa3); pv_one<1>(o[1], vb, pa0, pa1, pa2, pa3);
}
__device__ __forceinline__ void attn_unit(const bf16* __restrict__ Q, const bf16* __restrict__ K, const bf16* __restrict__ V, bf16* __restrict__ O,
                                          int qrow0, int h, int NT, int nx, int kx0, int kc0, LAS char* lds, const int wave, const float negB, const bool fixed, const float* qgain, const float* qrope) {
    int tid = wave * 64 + lane_id(); asm volatile("" : "+v"(tid));
    const int wid = wave, lane = tid & 63, r32 = lane & 31, hi = lane >> 5;
    LAS char* V_lds = lds + LDS_V; LAS char* K_lds = lds + LDS_K;
    LAS float* ws = (LAS float*)(lds + LDS_WS) + wid * 64; LAS float* li_l = ws; LAS float* al_l = ws + 32;
    float m_reg = -1e30f, l_reg = 0; f32x16 o[2]; o[0] = f32x16{}; o[1] = f32x16{}; bf16x8 qr[6];
    const bf16* Qw = Q + (size_t)(qrow0 + wid * 32 + r32) * 768 + h * 96 + hi * 8;
#pragma unroll
    for (int d0 = 0; d0 < 6; ++d0) qr[d0] = *(const bf16x8*)(Qw + d0 * 16);
    {
        float qf[6][8]; float ss = 0.f;
#pragma unroll
        for (int d0 = 0; d0 < 6; ++d0) { const u32x4 w = __builtin_bit_cast(u32x4, qr[d0]);
            qf[d0][0] = bflo(w.x); qf[d0][1] = bfhi(w.x); qf[d0][2] = bflo(w.y); qf[d0][3] = bfhi(w.y); qf[d0][4] = bflo(w.z); qf[d0][5] = bfhi(w.z); qf[d0][6] = bflo(w.w); qf[d0][7] = bfhi(w.w);
#pragma unroll
            for (int j = 0; j < 8; ++j) ss += qf[d0][j] * qf[d0][j]; }
        { auto rr = __builtin_amdgcn_permlane32_swap(__float_as_uint(ss), __float_as_uint(ss), false, false); ss = __uint_as_float(rr[0]) + __uint_as_float(rr[1]); }
        const float rinv = (1.0f / sqrtf(ss * (1.0f / QKH) + EPS)) * (0.10206207261596577f * 1.4426950408889634f);
#pragma unroll
        for (int d0 = 0; d0 < 6; ++d0) { const f32x4 g0 = *(const f32x4*)(qgain + d0 * 16 + hi * 8), g1 = *(const f32x4*)(qgain + d0 * 16 + hi * 8 + 4);
#pragma unroll
            for (int j = 0; j < 4; ++j) { qf[d0][j] *= rinv * g0[j]; qf[d0][4 + j] *= rinv * g1[j]; } }
        if (qrope) { const float* rp = qrope + (size_t)(wid * 32 + r32) * 32 + hi * 8;
            const f32x4 c0 = *(const f32x4*)rp, c1 = *(const f32x4*)(rp + 4), s0 = *(const f32x4*)(rp + 16), s1 = *(const f32x4*)(rp + 20);
#pragma unroll
            for (int j = 0; j < 8; ++j) { const float c = j < 4 ? c0[j & 3] : c1[j & 3], sn = j < 4 ? s0[j & 3] : s1[j & 3]; const float x1 = qf[4][j], x2 = qf[5][j]; qf[4][j] = x1 * c - x2 * sn; qf[5][j] = x2 * c + x1 * sn; } }
#pragma unroll
        for (int d0 = 0; d0 < 6; ++d0) { u32x4 w; w.x = pk2(qf[d0][0], qf[d0][1]); w.y = pk2(qf[d0][2], qf[d0][3]); w.z = pk2(qf[d0][4], qf[d0][5]); w.w = pk2(qf[d0][6], qf[d0][7]); qr[d0] = __builtin_bit_cast(bf16x8, w); }
    }
    const int vr = tid >> 3, vc = tid & 7, vst = v_st(vr, vc * 8);
    const int kr0 = tid / 12, kc0_ = tid % 12, kr1 = (tid + 512) / 12, kc1_ = (tid + 512) % 12; const bool k2 = tid < 256;
    const int kst0 = KSWZ(kr0, kc0_ * 16), kst1 = KSWZ(kr1, kc1_ * 16);
    const bf16* Kh = K + h * 96; const bf16* Vh = V + h * 128 + 64;
    const int vb0 = (int)(uintptr_t)V_lds + v_rd_base(lane);
    struct { bf16x8 vs, ks0, ks1; } sr_[2];
#define TROW(j) ((j) < nx ? kx0 + (j) * 64 : kc0 + ((j) - nx) * 64)
#define SLOAD(i, j) do { const int t0_ = TROW(j); sr_[i].vs = *(const bf16x8*)(Vh + (size_t)(t0_ + vr) * 1024 + vc * 8); \
    sr_[i].ks0 = *(const bf16x8*)(Kh + (size_t)(t0_ + kr0) * 768 + kc0_ * 8); if (k2) sr_[i].ks1 = *(const bf16x8*)(Kh + (size_t)(t0_ + kr1) * 768 + kc1_ * 8); } while (0)
#define SWRITE(slot, i) do { *(LAS bf16x8*)(V_lds + (slot) * SHM_V + vst) = sr_[i].vs; *(LAS bf16x8*)(K_lds + (slot) * SHM_K + kst0) = sr_[i].ks0; \
    if (k2) *(LAS bf16x8*)(K_lds + (slot) * SHM_K + kst1) = sr_[i].ks1; } while (0)
#define RESC(a) do { if (!fixed) { if (__any((a) < 1.f)) { if (hi == 0) al_l[r32] = (a); asm volatile("s_waitcnt lgkmcnt(0)" ::: "memory"); \
    _Pragma("unroll") for (int d = 0; d < 2; ++d) _Pragma("unroll") for (int r = 0; r < 16; ++r) o[d][r] *= al_l[crow(r, hi)]; } } } while (0)
#define ROT() do { const int t_ = sp; sp = sc; sc = sn; sn = t_; } while (0)
    f32x16 pA0, pA1, pB0, pB1; float mnA, mnB, alA, alB; bf16x8 pa0, pa1, pa2, pa3;
    int sp = 0, sc = 1, sn = 2;
    SLOAD(0, 0); asm volatile("s_waitcnt vmcnt(0)" ::: "memory"); SWRITE(0, 0); SLOAD(1, 1); __syncthreads();
    qkt(pA0, pA1, K_lds, qr, r32, hi, negB); partialSM(pA0, pA1, m_reg, mnA, alA, fixed);
    SWRITE(1, 1); if (2 < NT) SLOAD(0, 2);
    __syncthreads();
    for (int j = 1; j + 1 < NT; j += 2) {
        SBAR(); qkt(pB0, pB1, K_lds + sc * SHM_K, qr, r32, hi, negB);
        finishSM(pA0, pA1, alA, l_reg, pa0, pa1, pa2, pa3); SBAR();
        SLOAD(1, j + 2); SBAR();
        pv_all(o, vb0 + sp * SHM_V, pa0, pa1, pa2, pa3); partialSM(pB0, pB1, m_reg, mnB, alB, fixed);
        SWRITE(sn, 0);
        RESC(alB); __syncthreads(); ROT();
        SBAR(); qkt(pA0, pA1, K_lds + sc * SHM_K, qr, r32, hi, negB);
        finishSM(pB0, pB1, alB, l_reg, pa0, pa1, pa2, pa3); SBAR();
        if (j + 3 < NT) SLOAD(0, j + 3); SBAR();
        pv_all(o, vb0 + sp * SHM_V, pa0, pa1, pa2, pa3); partialSM(pA0, pA1, m_reg, mnA, alA, fixed);
        SWRITE(sn, 1);
        RESC(alA); __syncthreads(); ROT();
    }
    SBAR(); qkt(pB0, pB1, K_lds + sc * SHM_K, qr, r32, hi, negB);
    finishSM(pA0, pA1, alA, l_reg, pa0, pa1, pa2, pa3); SBAR();
    pv_all(o, vb0 + sp * SHM_V, pa0, pa1, pa2, pa3); partialSM(pB0, pB1, m_reg, mnB, alB, fixed);
    RESC(alB);
    finishSM(pB0, pB1, alB, l_reg, pa0, pa1, pa2, pa3); SBAR();
    pv_all(o, vb0 + sc * SHM_V, pa0, pa1, pa2, pa3);
    if (hi == 0) li_l[r32] = l_reg; asm volatile("s_waitcnt lgkmcnt(0)" ::: "memory");
    bf16* Ow = O + (size_t)(qrow0 + wid * 32) * 1024 + h * 64 + r32;
#pragma unroll
    for (int r = 0; r < 16; ++r) { const int orow = crow(r, hi); const float rl = __builtin_amdgcn_rcpf(li_l[orow]);
#pragma unroll
        for (int d0 = 0; d0 < 2; ++d0) Ow[(size_t)orow * 1024 + d0 * 32] = (bf16)f2bf(o[d0][r] * rl); }
    __syncthreads();
#undef TROW
#undef SLOAD
#undef SWRITE
#undef RESC
#undef ROT
}
#undef KSWZ
#undef SBAR
}

enum { IX = 0, IC, ICTX, ICC, IADAW, IADAB, IMIXG, IFFNG, IWIN, IQLG, IKVLG, IWUQ, IWUKV, IQNG, IKNG, ICONVW, ICONVB, ICLNG, ICLNB, IWOUT, IFG, IFU, IFD, IRW, IMG, IMU, IMD, N_IN };
struct Args { const float* in[N_IN]; float* out; unsigned char* ws; int ph_lo, ph_hi; };
struct Frame {
    LAS unsigned char* lds; volatile LAS unsigned* MISC; gu32* ctl;
    int wave, G, gw, NGW;
    unsigned char* ws; float* out;
};
__device__ __forceinline__ const float* inp(int i) { asm volatile("" : "+s"(i)); return (const float*)((const GAS float* const*)__builtin_amdgcn_kernarg_segment_ptr())[i]; }
constexpr int CW_CNT = 8192;
constexpr int CW_SSQ = 16384;

__device__ __forceinline__ void transpose_tile(const float* __restrict__ W, int ldw, int k0, int n0, bf16* __restrict__ WT, int ldwt, int drow0, LAS float* scr, int lane, const float* kgain = nullptr) {
    const int n4 = (lane & 15) * 4, kq = lane >> 4;
    f32x4 v[16];
#pragma unroll
    for (int it = 0; it < 16; ++it) v[it] = *(const f32x4*)(W + (size_t)(k0 + 4 * it + kq) * ldw + n0 + n4);
#pragma unroll
    for (int it = 0; it < 16; ++it) { const int k = 4 * it + kq; if (kgain) v[it] = v[it] * kgain[k0 + k]; *(LAS f32x4*)(scr + k * 64 + (n4 ^ (((k >> 3) & 7) << 2))) = v[it]; }
    LDS_WAIT(); asm volatile("" ::: "memory");
    const int c = lane & 7;
#pragma unroll
    for (int it = 0; it < 8; ++it) { const int nn = (lane >> 3) + 8 * it; float s[8];
#pragma unroll
        for (int j = 0; j < 8; ++j) { const int k = 8 * c + j; s[j] = scr[k * 64 + (nn ^ (c << 2))]; }
        u32x4 o; o.x = pk2(s[0], s[1]); o.y = pk2(s[2], s[3]); o.z = pk2(s[4], s[5]); o.w = pk2(s[6], s[7]);
        *(u32x4*)(WT + (size_t)(drow0 + nn) * ldwt + k0 + 8 * c) = o; }
    LDS_WAIT(); asm volatile("" ::: "memory");
}
__device__ __forceinline__ int gu_row(int n, int up) { return (n >> 7) * 256 + up * 128 + (n & 127); }

constexpr int TT_IN = 16 * 19, TT_UQ = 6 * 12, TT_UKV = 4 * 16, TT_OUT = 16 * 16, TT_SMALL = 2 * (TT_IN + TT_UQ + TT_UKV + TT_OUT), TT_FF = 3 * 704, TT_ALL = TT_SMALL + 9 * TT_FF;
__device__ __forceinline__ void transpose_item(unsigned char* ws, int it, LAS float* scr, int lane) {
    if (it < TT_SMALL) {
        const int l = it / (TT_SMALL / 2); int r = it % (TT_SMALL / 2);
        if (r < TT_IN) { const int nb = r % 19; int sc, dr;
            if (nb < 6) { sc = 64 * nb; dr = 64 * nb; } else if (nb == 6) { sc = 640; dr = C_KR; } else if (nb < 11) { sc = 384 + 64 * (nb - 7); dr = C_CKV + 64 * (nb - 7); }
            else if (nb < 13) { sc = 672 + 64 * (nb - 11); dr = 768 + 64 * (nb - 11); } else if (nb < 15) { sc = 928 + 64 * (nb - 13); dr = 896 + 64 * (nb - 13); }
            else if (nb < 17) { sc = 800 + 64 * (nb - 15); dr = 1024 + 64 * (nb - 15); } else { sc = 1056 + 64 * (nb - 17); dr = 1152 + 64 * (nb - 17); }
            transpose_tile(inp(IWIN) + (size_t)l * DM * INC, INC, (r / 19) * 64, sc, (bf16*)(ws + WS_WIN) + (size_t)l * NCOL * DM, DM, dr, scr, lane); return; } r -= TT_IN;
        if (r < TT_UQ) { transpose_tile(inp(IWUQ) + (size_t)l * QL * 768, 768, (r / 12) * 64, (r % 12) * 64, (bf16*)(ws + WS_WUQ) + (size_t)l * 768 * QL, QL, (r % 12) * 64, scr, lane, inp(IQLG) + l * QL); return; } r -= TT_UQ;
        if (r < TT_UKV) { transpose_tile(inp(IWUKV) + (size_t)l * KVL * 1024, 1024, (r / 16) * 64, (r % 16) * 64, (bf16*)(ws + WS_WUKV) + (size_t)l * 1024 * KVL, KVL, (r % 16) * 64, scr, lane, inp(IKVLG) + l * KVL); return; } r -= TT_UKV;
        transpose_tile(inp(IWOUT) + (size_t)l * DM * DM, DM, (r / 16) * 64, (r % 16) * 64, (bf16*)(ws + WS_WOUT) + (size_t)l * DM * DM, DM, (r % 16) * 64, scr, lane); return;
    }
    const int it2 = it - TT_SMALL, set = it2 / TT_FF, r = it2 % TT_FF, mat = r / 704, t = r % 704;
    const float* wg = set == 0 ? inp(IFG) : inp(IMG) + (size_t)(set - 1) * DM * DFF;
    const float* wu = set == 0 ? inp(IFU) : inp(IMU) + (size_t)(set - 1) * DM * DFF;
    const float* wd = set == 0 ? inp(IFD) : inp(IMD) + (size_t)(set - 1) * DFF * DM;
    bf16* dgu = set == 0 ? (bf16*)(ws + WS_WGU) : (bf16*)(ws + WS_MOEGU) + (size_t)(set - 1) * 2 * DFF * DM;
    bf16* dd = set == 0 ? (bf16*)(ws + WS_WD) : (bf16*)(ws + WS_MOED) + (size_t)(set - 1) * DM * DFF;
    if (mat < 2) { const int kb = t / 44, nb = t % 44; transpose_tile(mat == 0 ? wg : wu, DFF, kb * 64, nb * 64, dgu, DM, gu_row(nb * 64, mat), scr, lane); }
    else { const int kb = t / 16, nb = t % 16; transpose_tile(wd, DM, kb * 64, nb * 64, dd, DFF, nb * 64, scr, lane); }
}

__device__ __forceinline__ void prologue(const Args& a, Frame& F) {
    int lane_ = lane_id(), tid_ = F.wave * 64 + lane_; size_t z_ = 0; asm volatile("" : "+v"(lane_), "+v"(tid_), "+s"(z_)); unsigned char* ws_ = F.ws + z_;

    unsigned char* ws = ws_;
    LAS float* ldsf = (LAS float*)F.lds;
    for (int t = blockIdx.x; t < 192; t += F.G) {
        const int l = t / 96, cg = t % 96;
        for (int idx = tid_; idx < 9 * 1024; idx += 512) { const int bi = idx >> 10, k = idx & 1023; const float cv = bi < 8 ? inp(IC)[bi * 1024 + k] : inp(ICC)[k]; ldsf[idx] = cv / (1.0f + expf(-cv)); }
        __syncthreads();
        float acc[9];
#pragma unroll
        for (int bi = 0; bi < 9; ++bi) acc[bi] = 0.f;
        const float* wp = inp(IADAW) + ((size_t)l * 1024 + F.wave * 128) * 6144 + cg * 64 + lane_;
#pragma unroll 8
        for (int kk = 0; kk < 128; ++kk) { const float w = wp[(size_t)kk * 6144]; const int k = F.wave * 128 + kk;
#pragma unroll
            for (int bi = 0; bi < 9; ++bi) acc[bi] += ldsf[bi * 1024 + k] * w; }
        LAS float* red = ldsf + 9 * 1024;
#pragma unroll
        for (int bi = 0; bi < 9; ++bi) red[(F.wave * 9 + bi) * 64 + lane_] = acc[bi];
        __syncthreads();
        for (int idx = tid_; idx < 576; idx += 512) { const int bi = idx >> 6, c = idx & 63; float s = inp(IADAB)[l * 6144 + cg * 64 + c];
#pragma unroll
            for (int w = 0; w < 8; ++w) s += red[(w * 9 + bi) * 64 + c];
            ((float*)(ws + WS_MOD))[(size_t)(l * 9 + bi) * 6144 + cg * 64 + c] = s; }
        __syncthreads();
    }
    for (int t = blockIdx.x; t < 128; t += F.G) {
        const int l = t >> 6, g = (t >> 4) & 3, k0 = (t & 15) * 64;
        LAS float* Wl = ldsf; LAS float* tab = ldsf + 64 * 65;
        { const int k = tid_ >> 3, c8 = (tid_ & 7) * 8; const float* src = inp(IWIN) + ((size_t)l * DM + k0 + k) * INC + OFF_FOUR + g * 64 + c8;
          const f32x4 v0 = *(const f32x4*)src, v1 = *(const f32x4*)(src + 4);
#pragma unroll
          for (int e = 0; e < 4; ++e) { Wl[k * 65 + c8 + e] = v0[e]; Wl[k * 65 + c8 + 4 + e] = v1[e]; } }
        if (tid_ < 64) { tab[tid_] = cospif((float)tid_ / 32.0f); tab[64 + tid_] = sinpif((float)tid_ / 32.0f); }
        __syncthreads();
        const int k = tid_ & 63;
        for (int i = 0; i < 16; ++i) { const int pc = (tid_ >> 6) + 8 * i, part = pc >> 6, cp = pc & 63; float s = 0.f;
#pragma unroll 8
            for (int c = 0; c < 64; ++c) s += Wl[k * 65 + c] * tab[part * 64 + ((c * cp) & 63)];
            ((bf16*)(ws + WS_WFT))[((size_t)l * 512 + part * 256 + g * 64 + cp) * DM + k0 + k] = (bf16)f2bf(0.125f * s); }
        __syncthreads();
    }
    {
        LAS float* ctab = ldsf;
        for (int m = tid_; m < 2048; m += 512) ctab[m] = cospif((float)m / 1024.0f);
        __syncthreads();
        const float sc = 0.02209708691207961f;
        for (int k = blockIdx.x; k < 256; k += F.G) {
            if (tid_ < 64) { const int kk0 = tid_ * 8; unsigned w[4];
#pragma unroll
                for (int e = 0; e < 8; e += 2) { float v[2];
#pragma unroll
                    for (int q = 0; q < 2; ++q) { const int kk = kk0 + e + q; const int s = kk & 255; const int m = ((k * s) & 255) * 8; v[q] = kk < 256 ? ctab[m] * 0.0625f : -ctab[(m - 512) & 2047] * 0.0625f; }
                    w[e >> 1] = pk2(v[0], v[1]); }
                *(u32x4*)((bf16*)(ws + WS_DFTC) + (size_t)k * 512 + kk0) = (u32x4){w[0], w[1], w[2], w[3]}; }
        }
        __syncthreads();
    }
    for (int e = blockIdx.x * 512 + tid_; e < 2048 * 16; e += F.G * 512) { const int t = e >> 4, i = e & 15; const float pos = (float)(i < 8 ? (t >> 6) : (t & 63));
        const float inv = powf(10000.0f, -(float)(i & 7) * 0.125f); const float ang = pos * inv;
        ((float*)(ws + WS_ROPE))[t * 32 + i] = cosf(ang); ((float*)(ws + WS_ROPE))[t * 32 + 16 + i] = sinf(ang); }
    for (int e = blockIdx.x * 512 + tid_; e < 2 * 64 * DM / 8; e += F.G * 512) { const int l = e / (64 * DM / 8), r = e % (64 * DM / 8);
        *(u32x4*)((bf16*)(ws + WS_WIN) + ((size_t)l * NCOL + 448) * DM + (size_t)r * 8) = (u32x4){0u, 0u, 0u, 0u}; }
    { LAS float* scr = ldsf + F.wave * 4096;
      for (int it = F.gw; it < TT_ALL; it += F.NGW) transpose_item(ws, it, scr, lane_); }
}

__device__ __forceinline__ const float* modp(const unsigned char* ws, int l, int bi, int which) { return (const float*)(ws + WS_MOD) + (size_t)(l * 9 + bi) * 6144 + which * 1024; }

template <bool ROUTER>
__device__ __forceinline__ void adaln_pass(const Frame& F, int l, int wsh, const float* gain, const float* srcx, const float* srcc, bool do_ctx, const float* router_w) {
    int lane_ = lane_id(), tid_ = F.wave * 64 + lane_; size_t z_ = 0; asm volatile("" : "+v"(lane_), "+v"(tid_), "+s"(z_)); unsigned char* ws_ = F.ws + z_;

    bf16* h = (bf16*)(ws_ + DY_H);
    LAS float* rwl = (LAS float*)F.lds;
    if (ROUTER) { for (int idx = tid_; idx < 8192; idx += 512) { const int k = idx >> 3, e = idx & 7; rwl[e * 1024 + k] = router_w[idx]; } __syncthreads(); }
    for (int gwi = F.gw; gwi < 2048; gwi += F.NGW) {
        for (int pass = 0; pass < (do_ctx ? 2 : 1); ++pass) {
            const int bi = pass == 0 ? (gwi >> 8) : 8;
            const float* sh = modp(ws_, l, bi, wsh); const float* sc = modp(ws_, l, bi, wsh + 1);
            f32x4 A[4], Bv[4];
#pragma unroll
            for (int j = 0; j < 4; ++j) { const int col = 256 * j + 4 * lane_; const f32x4 g4 = *(const f32x4*)(gain + col), s4 = *(const f32x4*)(sc + col); A[j] = g4 * (1.0f + s4); Bv[j] = *(const f32x4*)(sh + col); }
            const int nrow = pass == 0 ? 8 : 1;
            for (int rr = 0; rr < nrow; ++rr) {
                const int r = pass == 0 ? gwi * 8 + rr : gwi;
                const float* src = (pass == 0 ? srcx : srcc) + (size_t)r * DM;
                bf16* dst = h + (size_t)(pass == 0 ? r : RX + r) * DM;
                f32x4 v[4]; float ss = 0.f;
#pragma unroll
                for (int j = 0; j < 4; ++j) { v[j] = *(const f32x4*)(src + 256 * j + 4 * lane_); ss += (v[j].x * v[j].x + v[j].y * v[j].y) + (v[j].z * v[j].z + v[j].w * v[j].w); }
                const float rinv = 1.0f / sqrtf(wave_sum(ss) * (1.0f / DM) + EPS);
#pragma unroll
                for (int j = 0; j < 4; ++j) { v[j] = v[j] * rinv * A[j] + Bv[j];
                    u32x2 o; o.x = pk2(v[j].x, v[j].y); o.y = pk2(v[j].z, v[j].w); *(u32x2*)(dst + 256 * j + 4 * lane_) = o; }
                if (ROUTER) {
                    float lg[8];
#pragma unroll
                    for (int e = 0; e < 8; ++e) { float s = 0.f;
#pragma unroll
                        for (int j = 0; j < 4; ++j) { const f32x4 w4 = *(const LAS f32x4*)(rwl + e * 1024 + 256 * j + 4 * lane_); s += (v[j].x * w4.x + v[j].y * w4.y) + (v[j].z * w4.z + v[j].w * w4.w); }
                        lg[e] = wave_sum(s); }
                    int e0 = 0; float l0 = lg[0];
#pragma unroll
                    for (int e = 1; e < 8; ++e) if (lg[e] > l0) { l0 = lg[e]; e0 = e; }
                    int e1 = -1; float l1 = -3.0e38f;
#pragma unroll
                    for (int e = 0; e < 8; ++e) if (e != e0 && lg[e] > l1) { l1 = lg[e]; e1 = e; }
                    const float w0 = 1.0f / (1.0f + expf(l1 - l0));
                    if (lane_ == 0) { ((int*)(ws_ + WS_MOE + MO_TOKE))[r] = e0 | (e1 << 8); ((float*)(ws_ + WS_MOE + MO_TOKW))[2 * r] = w0; ((float*)(ws_ + WS_MOE + MO_TOKW))[2 * r + 1] = 1.0f - w0;
                        atomicAdd((int*)F.ctl + CW_CNT + (r >> 6) * 16 + e0, 1); atomicAdd((int*)F.ctl + CW_CNT + (r >> 6) * 16 + 8 + e1, 1); }
                }
            }
        }
    }
}

__device__ __forceinline__ void conv_pass(const Frame& F, const float* cw, const float* cb, const float* lg, const float* lb, const int wg0) {
    int lane_ = lane_id(), tid_ = F.wave * 64 + lane_; size_t z_ = 0; asm volatile("" : "+v"(lane_), "+v"(tid_), "+s"(z_)); unsigned char* ws_ = F.ws + z_;

    const bf16* y = (const bf16*)(ws_ + DY_Y); bf16* mix = (bf16*)(ws_ + DY_M);
    const int ch = 4 * lane_;
    LAS float* wl = (LAS float*)F.lds;
    __syncthreads();
    for (int idx = tid_; idx < 45 * CCH; idx += 512) { const int jj = idx >> 8; wl[idx] = (jj >= 7 && jj < 7 + CWID) ? cw[idx - 7 * CCH] : 0.f; }
    __syncthreads();
    const f32x4 bv = *(const f32x4*)(cb + ch), gv = *(const f32x4*)(lg + ch), bb = *(const f32x4*)(lb + ch);
    for (int ct = F.gw - wg0 * 8; ct < RT / 8; ct += F.NGW - wg0 * 8) {
        const int r0 = ct * 8;
        const int s0 = r0 < RX ? (r0 & ~(SEQ - 1)) : RX + ((r0 - RX) & ~(CTXL - 1)), s1 = s0 + (r0 < RX ? SEQ : CTXL);
        u32x2 yr[8 + CWID - 1];
#pragma unroll
        for (int i = 0; i < 8 + CWID - 1; ++i) { const int rr = r0 - 15 + i; yr[i] = (u32x2){0u, 0u}; if (rr >= s0 && rr < s1) yr[i] = *(const u32x2*)(y + (size_t)rr * CCH + ch); }
        f32x4 acc[8];
#pragma unroll
        for (int o = 0; o < 8; ++o) acc[o] = bv;
#pragma unroll
        for (int i = 0; i < 8 + CWID - 1; ++i) { const f32x4 yv = (f32x4){bflo(yr[i].x), bfhi(yr[i].x), bflo(yr[i].y), bfhi(yr[i].y)};
#pragma unroll
            for (int o = 0; o < 8; ++o) { const int j = i - o; if (j >= 0 && j < CWID) acc[o] += yv * *(const LAS f32x4*)(wl + (j + 7) * CCH + ch); } }
#pragma unroll
        for (int o = 0; o < 8; ++o) { const f32x4 v = acc[o];
            const float mean = wave_sum((v.x + v.y) + (v.z + v.w)) * (1.0f / CCH); const f32x4 d = v - mean;
            const float var = wave_sum((d.x * d.x + d.y * d.y) + (d.z * d.z + d.w * d.w)) * (1.0f / CCH); const float rs = 1.0f / sqrtf(var + EPS);
            const f32x4 n = d * rs * gv + bb;
            u32x2 w; w.x = pk2(siluf_(n.x), siluf_(n.y)); w.y = pk2(siluf_(n.z), siluf_(n.w));
            *(u32x2*)(mix + (size_t)(r0 + o) * DM + 512 + ch) = w; }
    }
}

__device__ __forceinline__ void fft_stage_a(const Frame& F) {
    int lane_ = lane_id(), tid_ = F.wave * 64 + lane_; size_t z_ = 0; asm volatile("" : "+v"(lane_), "+v"(tid_), "+s"(z_)); unsigned char* ws_ = F.ws + z_;
    LAS float* ctab = (LAS float*)F.lds;
    __syncthreads();
    for (int m = tid_; m < 2048; m += 512) ctab[m] = cospif((float)m / 1024.0f);
    __syncthreads();
    const float R = 0.70710678118654752f, IS8 = 0.35355339059327376f;
    const float c8[8] = {1.f, R, 0.f, -R, -1.f, -R, 0.f, R}, s8[8] = {0.f, R, 1.f, R, 0.f, -R, -1.f, -R};
    for (int row = F.gw; row < NB * 256; row += F.NGW) {
        bf16* zr = (bf16*)(ws_ + DY_Z) + (size_t)row * 4096 + 4 * lane_;
        float yr[8][4], yi[8][4];
#pragma unroll
        for (int s1 = 0; s1 < 8; ++s1) { const u32x2 a = *(const u32x2*)(zr + 256 * s1), b = *(const u32x2*)(zr + 2048 + 256 * s1);
            yr[s1][0] = bflo(a.x); yr[s1][1] = bfhi(a.x); yr[s1][2] = bflo(a.y); yr[s1][3] = bfhi(a.y);
            yi[s1][0] = -bflo(b.x); yi[s1][1] = -bfhi(b.x); yi[s1][2] = -bflo(b.y); yi[s1][3] = -bfhi(b.y); }
#pragma unroll
        for (int k1 = 0; k1 < 8; ++k1) { float pr[4], pi[4];
#pragma unroll
            for (int e = 0; e < 4; ++e) { float ar = 0.f, ai = 0.f;
#pragma unroll
                for (int s1 = 0; s1 < 8; ++s1) { const float c = c8[(k1 * s1) & 7], sn = s8[(k1 * s1) & 7]; ar += yr[s1][e] * c + yi[s1][e] * sn; ai += yi[s1][e] * c - yr[s1][e] * sn; }
                const int m = (k1 * (4 * lane_ + e)) & 2047; const float cb = ctab[m], sb = ctab[(m - 512) & 2047];
                pr[e] = (ar * cb + ai * sb) * IS8; pi[e] = -(ai * cb - ar * sb) * IS8; }
            u32x2 o0, o1; o0.x = pk2(pr[0], pr[1]); o0.y = pk2(pr[2], pr[3]); o1.x = pk2(pi[0], pi[1]); o1.y = pk2(pi[2], pi[3]);
            *(u32x2*)(zr + k1 * 512) = o0; *(u32x2*)(zr + k1 * 512 + 256) = o1; }
    }
}

__device__ __forceinline__ void t5_pass(const Frame& F, const float* qg, const float* kg) {
    int lane_ = lane_id(), tid_ = F.wave * 64 + lane_; size_t z_ = 0; asm volatile("" : "+v"(lane_), "+v"(tid_), "+s"(z_)); unsigned char* ws_ = F.ws + z_;

    bf16* q = (bf16*)(ws_ + DY_Q); const bf16* kvp = (const bf16*)(ws_ + DY_KV); const bf16* cols = (const bf16*)(ws_ + DY_C); bf16* kk = (bf16*)(ws_ + DY_K);
    const float* rope = (const float*)(ws_ + WS_ROPE);
    const int hh = lane_ >> 3, sub = lane_ & 7; const float QS = 0.10206207261596577f * 1.4426950408889634f;
    float gqn[8], gkn[8], gqr[4], gkr[4];
#pragma unroll
    for (int e = 0; e < 8; ++e) { gqn[e] = qg[8 * sub + e]; gkn[e] = kg[8 * sub + e]; }
#pragma unroll
    for (int e = 0; e < 2; ++e) { gqr[e] = qg[64 + 2 * sub + e]; gqr[2 + e] = qg[80 + 2 * sub + e]; gkr[e] = kg[64 + 2 * sub + e]; gkr[2 + e] = kg[80 + 2 * sub + e]; }
    for (int r = F.gw; r < RT; r += F.NGW) {
        float cs[2] = {1.f, 1.f}, sn[2] = {0.f, 0.f};
        if (r < RX) { const int t = r & (SEQ - 1); cs[0] = rope[t * 32 + 2 * sub]; cs[1] = rope[t * 32 + 2 * sub + 1]; sn[0] = rope[t * 32 + 16 + 2 * sub]; sn[1] = rope[t * 32 + 16 + 2 * sub + 1]; }
#pragma unroll
        for (int isk = 1; isk < 2; ++isk) {
            const bf16* pn = isk ? kvp + (size_t)r * 1024 + hh * 128 + 8 * sub : q + (size_t)r * 768 + hh * 96 + 8 * sub;
            const bf16* p1 = isk ? cols + (size_t)r * NC3 + C_KR + 2 * sub : q + (size_t)r * 768 + hh * 96 + 64 + 2 * sub;
            const u32x4 wn = *(const u32x4*)pn; const unsigned w1 = *(const unsigned*)p1, w2 = *(const unsigned*)(p1 + 16);
            float v[8] = {bflo(wn.x), bfhi(wn.x), bflo(wn.y), bfhi(wn.y), bflo(wn.z), bfhi(wn.z), bflo(wn.w), bfhi(wn.w)};
            float x1[2] = {bflo(w1), bfhi(w1)}, x2[2] = {bflo(w2), bfhi(w2)};
            float ss = x1[0] * x1[0] + x1[1] * x1[1] + x2[0] * x2[0] + x2[1] * x2[1];
#pragma unroll
            for (int e = 0; e < 8; ++e) ss += v[e] * v[e];
            ss = sum8(ss);
            const float rinv = (1.0f / sqrtf(ss * (1.0f / QKH) + EPS)) * (isk ? 1.0f : QS);
            const float* gn = isk ? gkn : gqn; const float* gr = isk ? gkr : gqr;
#pragma unroll
            for (int e = 0; e < 8; ++e) v[e] *= rinv * gn[e];
#pragma unroll
            for (int e = 0; e < 2; ++e) { x1[e] *= rinv * gr[e]; x2[e] *= rinv * gr[2 + e]; }
            const float o1a = x1[0] * cs[0] - x2[0] * sn[0], o1b = x1[1] * cs[1] - x2[1] * sn[1], o2a = x2[0] * cs[0] + x1[0] * sn[0], o2b = x2[1] * cs[1] + x1[1] * sn[1];
            bf16* dn = (isk ? kk : q) + (size_t)r * 768 + hh * 96;
            u32x4 o; o.x = pk2(v[0], v[1]); o.y = pk2(v[2], v[3]); o.z = pk2(v[4], v[5]); o.w = pk2(v[6], v[7]);
            *(u32x4*)(dn + 8 * sub) = o; *(unsigned*)(dn + 64 + 2 * sub) = pk2(o1a, o1b); *(unsigned*)(dn + 80 + 2 * sub) = pk2(o2a, o2b);
        }
    }
}

__device__ __forceinline__ void moe_assign(const Frame& F, int k) {
    int lane_ = lane_id(), tid_ = F.wave * 64 + lane_; size_t z_ = 0; asm volatile("" : "+v"(lane_), "+v"(tid_), "+s"(z_)); unsigned char* ws_ = F.ws + z_;
    LAS int* li = (LAS int*)F.lds;
    const int* cnt = (const int*)F.ctl + CW_CNT;
    const int* toke = (const int*)(ws_ + WS_MOE + MO_TOKE); const float* tokw = (const float*)(ws_ + WS_MOE + MO_TOKW);
    int* srow = (int*)(ws_ + WS_MOE + MO_SROW) + k * 32768; float* sw = (float*)(ws_ + WS_MOE + MO_SW) + k * 32768; int* meta = (int*)(ws_ + WS_MOE + MO_META) + 16 * k;
    const bf16* h = (const bf16*)(ws_ + DY_H); bf16* hg = (bf16*)(ws_ + DY_M);
    for (int rg = blockIdx.x; rg < 256; rg += F.G) {
        { const int e = F.wave; int tot = 0, bef = 0;
#pragma unroll
            for (int q = 0; q < 4; ++q) { const int g = 4 * lane_ + q; const int c = __hip_atomic_load(cnt + g * 16 + 8 * k + e, RLX_AGENT); tot += c; bef += g < rg ? c : 0; }
            tot = wave_isum(tot); bef = wave_isum(bef);
            if (lane_ == 0) { li[2048 + e] = tot; li[2056 + e] = bef; } }
        __syncthreads();
        if (tid_ == 0) { int pb = 0; for (int e = 0; e < 8; ++e) { li[2064 + e] = pb * 256; if (rg == 0) meta[e] = pb; pb += (li[2048 + e] + 255) >> 8; } li[2072] = pb * 256; if (rg == 0) meta[8] = pb; }
        __syncthreads();
        if (F.wave == 0) { const int r = rg * 64 + lane_; const int ek = (toke[r] >> (8 * k)) & 0xff; int rank = 0;
#pragma unroll
            for (int e = 0; e < 8; ++e) { const unsigned long long m = __ballot(ek == e); if (ek == e) rank = __popcll(m & ((1ull << lane_) - 1ull)); }
            const int slot = li[2064 + ek] + li[2056 + ek] + rank; srow[slot] = r; sw[slot] = tokw[2 * r + k]; li[2080 + lane_] = slot; }
        if (rg == 0) { for (int e = 0; e < 8; ++e) { const int b0 = li[2064 + e] + li[2048 + e], b1 = li[2064 + e + 1]; for (int s2 = b0 + tid_; s2 < b1; s2 += 512) { srow[s2] = -1; sw[s2] = 0.f; } } }
        __syncthreads();
        for (int i = F.wave * 8; i < F.wave * 8 + 8; ++i) { const int slot = li[2080 + i]; const u32x4* src = (const u32x4*)(h + (size_t)(rg * 64 + i) * DM); u32x4* dst = (u32x4*)(hg + (size_t)slot * DM);
            dst[lane_] = src[lane_]; dst[64 + lane_] = src[64 + lane_]; }
        __syncthreads();
    }
}

using pg8::Unit;
struct SchedIn {
    int G, c, l; unsigned char* ws;
    __device__ __forceinline__ bool next(int i, Unit& u) const { int L = i * G + c; if (L < 360) { u.pm = L / 5; u.pn = L % 5; return true; } L -= 360; if (L >= 144) return false; u.pm = 72 + L / 72; u.pn = L % 72; return true; }
    __device__ __forceinline__ const char* aptr(const Unit& u) const { return u.pm < 72 ? (const char*)(ws + DY_H) + (size_t)u.pm * 256 * DM * 2 : (const char*)(ws + WS_WFT) + ((size_t)l * 512 + (u.pm - 72) * 256) * DM * 2; }
    __device__ __forceinline__ const char* bptr(const Unit& u) const { return u.pm < 72 ? (const char*)(ws + WS_WIN) + ((size_t)l * NCOL + u.pn * 256) * DM * 2 : (const char*)(ws + DY_H) + (size_t)u.pn * 256 * DM * 2; }
};
struct EpiIn {
    static constexpr bool PERM = true; unsigned char* ws; float* ssq;
    __device__ __forceinline__ void operator()(const f32x4 (&acc)[2][2][4][2], const Unit& u, int wr, int wc, int fr, int fq) const {
        if (u.pm < 72) {
            bf16* C = (bf16*)(ws + DY_C) + (size_t)u.pm * 256 * NC3 + u.pn * 256;
            if (u.pn == 0) pg8::store_tile_bf16_ssq<2>(acc, C, NC3, ssq + (size_t)u.pm * 256 * 12 + wc, wr, wc, fr, fq);
            else if (u.pn == 1) pg8::store_tile_bf16_ssq<1>(acc, C, NC3, ssq + (size_t)u.pm * 256 * 12 + 4 + wc, wr, wc, fr, fq);
            else if (u.pn == 2) pg8::store_tile_bf16_ssq<2>(acc, C, NC3, ssq + (size_t)u.pm * 256 * 12 + 8 + wc, wr, wc, fr, fq);
            else pg8::store_tile_glu(acc, (bf16*)(ws + DY_Y) + (size_t)u.pm * 256 * CCH + (u.pn - 3) * 128, CCH, wr, wc, fr, fq);
        }
        else if (u.pn < 64) pg8::store_tile_bf16(acc, (bf16*)(ws + DY_Z) + ((size_t)(u.pn >> 3) * 256) * 4096 + (u.pm - 72) * 2048 + (u.pn & 7) * 256, 4096, wr, wc, fr, fq);
        else pg8::store_tile_bf16(acc, (bf16*)(ws + DY_Z + 16 * MiB) + (size_t)(u.pn - 64) * 256 * 512 + (u.pm - 72) * 256, 512, wr, wc, fr, fq);
    }
};
template <int LDC, int KDIM>
struct EpiUp {
    static constexpr bool PERM = true; bf16* C; const float* ssq;
    __device__ __forceinline__ void operator()(const f32x4 (&acc)[2][2][4][2], const Unit& u, int wr, int wc, int fr, int fq) const {
        pg8::store_tile_bf16_rs<KDIM == QL ? 8 : 4>(acc, C + (size_t)u.pm * 256 * LDC + u.pn * 256, LDC, ssq + (size_t)u.pm * 256 * 12, 1.0f / KDIM, wr, wc, fr, fq);
    }
};
template <int NPAN, int NTN, int LDA, int LDB, int ROT = 0>
struct SchedPlain {
    int G, c; const char* A; const char* B;
    __device__ __forceinline__ bool next(int i, Unit& u) const { const int cc = ROT ? (c + ROT) % G : c; const int L = i * G + cc; if (L >= NPAN * NTN) return false; u.pm = L / NTN; u.pn = L % NTN; return true; }
    __device__ __forceinline__ const char* aptr(const Unit& u) const { return A + (size_t)u.pm * 256 * LDA * 2; }
    __device__ __forceinline__ const char* bptr(const Unit& u) const { return B + (size_t)u.pn * 256 * LDB * 2; }
};
template <int LDC, bool SWIGLU>
struct EpiPlain {
    static constexpr bool PERM = true; bf16* C;
    __device__ __forceinline__ void operator()(const f32x4 (&acc)[2][2][4][2], const Unit& u, int wr, int wc, int fr, int fq) const {
        if (SWIGLU) pg8::store_tile_swiglu(acc, C + (size_t)u.pm * 256 * LDC + u.pn * 128, LDC, wr, wc, fr, fq);
        else pg8::store_tile_bf16(acc, C + (size_t)u.pm * 256 * LDC + u.pn * 256, LDC, wr, wc, fr, fq);
    }
};
struct SchedGUa {
    int G, c; const char* A; const char* B;
    __device__ __forceinline__ bool next(int i, Unit& u) const { const int L = i * G + c; if (L >= 256) return false; if (L < 176) { u.pm = 64 + L / 22; u.pn = L % 22; } else { const int j = L - 176; u.pm = j / 22; u.pn = j % 22; } return true; }
    __device__ __forceinline__ const char* aptr(const Unit& u) const { return A + (size_t)u.pm * 256 * DM * 2; }
    __device__ __forceinline__ const char* bptr(const Unit& u) const { return B + (size_t)u.pn * 256 * DM * 2; }
};
struct SchedGUb {
    int G, c; const char* A; const char* B;
    __device__ __forceinline__ bool next(int i, Unit& u) const {
        int j;
        if (G == 256) { if (c < 32) { if (i >= 3) return false; j = 80 + c * 3 + i; } else { j = 176 + (c - 32) + 224 * i; } }
        else j = 80 + i * G + c;
        if (j >= 64 * 22) return false; u.pm = j / 22; u.pn = j % 22; return true; }
    __device__ __forceinline__ const char* aptr(const Unit& u) const { return A + (size_t)u.pm * 256 * DM * 2; }
    __device__ __forceinline__ const char* bptr(const Unit& u) const { return B + (size_t)u.pn * 256 * DM * 2; }
};
template <int NPM, int K>
struct SchedDft {
    int G, c; const char* dft; const char* zt;
    __device__ __forceinline__ bool next(int i, Unit& u) const { const int L = i * G + c; if (L >= NB * NPM) return false; u.pm = L / NPM; u.pn = L % NPM; return true; }
    __device__ __forceinline__ const char* aptr(const Unit& u) const { return dft + (size_t)u.pn * 256 * K * 2; }
    __device__ __forceinline__ const char* bptr(const Unit& u) const { return zt + (size_t)u.pm * 256 * K * 2; }
};
template <int ROWS_PER_B>
struct EpiDft {
    static constexpr bool PERM = true; bf16* mix0;
    __device__ __forceinline__ void operator()(const f32x4 (&acc)[2][2][4][2], const Unit& u, int wr, int wc, int fr, int fq) const {
        pg8::store_tile_bf16(acc, mix0 + (size_t)(u.pm * ROWS_PER_B + u.pn * 256) * DM, DM, wr, wc, fr, fq);
    }
};
struct SchedFftC {
    int G, c; const char* dft; const char* zt;
    __device__ __forceinline__ bool next(int i, Unit& u) const { const int L = i * G + c; if (L >= NB * 8) return false; u.pm = L >> 3; u.pn = L & 7; return true; }
    __device__ __forceinline__ const char* aptr(const Unit&) const { return dft; }
    __device__ __forceinline__ const char* bptr(const Unit& u) const { return zt + ((size_t)u.pm * 256 * 4096 + u.pn * 512) * 2; }
};
struct EpiFftC {
    static constexpr bool PERM = true; bf16* mix0;
    __device__ __forceinline__ void operator()(const f32x4 (&acc)[2][2][4][2], const Unit& u, int wr, int wc, int fr, int fq) const {
        pg8::store_tile_bf16(acc, mix0 + (size_t)(u.pm * SEQ + u.pn) * DM, 8 * DM, wr, wc, fr, fq);
    }
};
template <int LDA>
struct SchedResid {
    int G, c, pm0, npan; const char* A; const char* B;
    __device__ __forceinline__ bool next(int i, Unit& u) const { const int L = i * G + c; if (L >= npan * 4) return false; u.pm = pm0 + (L >> 2); u.pn = L & 3; return true; }
    __device__ __forceinline__ const char* aptr(const Unit& u) const { return A + (size_t)u.pm * 256 * LDA * 2; }
    __device__ __forceinline__ const char* bptr(const Unit& u) const { return B + (size_t)u.pn * 256 * LDA * 2; }
};
struct EpiResid {
    static constexpr bool PERM = false;
    const float* xin; const float* cin; float* xout; float* cout; const float* gate;
    __device__ __forceinline__ void operator()(const f32x4 (&acc)[2][2][4][2], const Unit& u, int wr, int wc, int fr, int fq) const {
        if (u.pm < 64) { const size_t off = (size_t)u.pm * 256 * DM + u.pn * 256; pg8::store_tile_resid(acc, xin + off, xout + off, gate + (size_t)(u.pm >> 3) * 6144 + u.pn * 256, wr, wc, fr, fq); }
        else { const size_t off = (size_t)(u.pm - 64) * 256 * DM + u.pn * 256; pg8::store_tile_resid(acc, cin + off, cout + off, gate + (size_t)8 * 6144 + u.pn * 256, wr, wc, fr, fq); }
    }
};
template <int MODE>
struct SchedMoe {
    static constexpr bool DOWN = MODE >= 2;
    int G, c; const int* meta; unsigned char* ws;
    __device__ __forceinline__ bool next(int i, Unit& u) const {
        const int NP = __builtin_amdgcn_readfirstlane(meta[8]); int ned = 4 * NP - G; ned = ned < 0 ? 0 : ned; { const int cap = (G / 22) * 4; ned = ned > cap ? cap : ned; } ned &= ~3;
        if (MODE == 0) { const int L = i * G + c; if (i > 0 || L >= NP * 22) return false; u.pm = L / 22; u.pn = L % 22; return true; }
        if (MODE == 1) { int j; if (c < ned) { if (i >= 3) return false; j = G + c * 3 + i; } else { j = G + 3 * ned + (c - ned) + (G - ned) * i; } if (j >= NP * 22) return false; u.pm = j / 22; u.pn = j % 22; return true; }
        if (MODE == 2) { const int L = i * G + c; if (L >= ned) return false; u.pm = L >> 2; u.pn = L & 3; return true; }
        { const int L = i * G + c; const int ne = ned >> 2; if (L >= (NP - ne) * 4) return false; u.pm = ne + (L >> 2); u.pn = L & 3; return true; }
    }
    __device__ __forceinline__ int expert(int sp) const { int e = 0;
#pragma unroll
        for (int j = 1; j < 8; ++j) e += sp >= __builtin_amdgcn_readfirstlane(meta[j]) ? 1 : 0;
        return e; }
    __device__ __forceinline__ const char* aptr(const Unit& u) const { return DOWN ? (const char*)(ws + DY_ACT) + (size_t)u.pm * 256 * DFF * 2 : (const char*)(ws + DY_M) + (size_t)u.pm * 256 * DM * 2; }
    __device__ __forceinline__ const char* bptr(const Unit& u) const { const int e = expert(u.pm);
        return DOWN ? (const char*)(ws + WS_MOED) + ((size_t)e * DM + u.pn * 256) * DFF * 2 : (const char*)(ws + WS_MOEGU) + ((size_t)e * 2 * DFF + u.pn * 256) * DM * 2; }
};
struct EpiMoeDown {
    static constexpr bool PERM = false;
    const int* srow; const float* sw; const float* gate; float* out;
    __device__ __forceinline__ void operator()(const f32x4 (&acc)[2][2][4][2], const Unit& u, int wr, int wc, int fr, int fq) const {
        const int col0 = u.pn * 256 + wc * 32 + 4 * fq;
#pragma unroll
        for (int ai = 0; ai < 2; ++ai)
#pragma unroll
            for (int m = 0; m < 4; ++m) { const int slot = u.pm * 256 + ai * 128 + wr * 64 + m * 16 + fr; const int tok = srow[slot];
                if (tok >= 0) { const float w = sw[slot]; const float* g = gate + (size_t)(tok >> 11) * 6144 + col0; float* orow = out + (size_t)tok * DM + col0;
#pragma unroll
                    for (int bj = 0; bj < 2; ++bj)
#pragma unroll
                        for (int n = 0; n < 2; ++n) { const f32x4 gv = *(const f32x4*)(g + bj * 128 + n * 16); const f32x4 xv = *(const f32x4*)(orow + bj * 128 + n * 16);
                            *(f32x4*)(orow + bj * 128 + n * 16) = xv + gv * w * acc[ai][bj][m][n]; } } }
    }
};

#ifndef EN_MASK
#define EN_MASK 0xFFFFFFFFu
#endif
#ifndef PROBE_SITE
#define PROBE_SITE -1
#endif
#define RPT(n) for (int rep_ = 0; rep_ < ((PROBE_SITE) == (n) ? 2 : 1); ++rep_)
#define EN(n) (((EN_MASK) >> (n)) & 1u)
#define IN(k) (lo <= (k) && (k) < hi)
#define SEAM(k) do { if (!MK_PER_PHASE && IN(k) && IN((k) + 1)) xcd_barrier(bar); } while (0)
#define SITE if (PROBE_SITE >= 0 && rep_ > 0) xcd_barrier(bar); size_t z_ = 0; int cid = blockIdx.x, G = gridDim.x; if ((G & 7) == 0) cid = (cid & 7) * (G >> 3) + (cid >> 3); asm volatile("" : "+s"(z_), "+s"(cid), "+s"(G)); unsigned char* ws = a.ws + z_;

template <int L>
__device__ __forceinline__ void mixer_phases(const Args& a, Frame& F, const XcdBarrier& bar, const int lo, const int hi) {
    constexpr int rep_ = 0; (void)rep_;
    constexpr int P = L == 0 ? 1 : 11;
    LAS unsigned char* ring = F.lds;
    RPT(1) if (EN(1) && IN(P + 0)) { SITE adaln_pass<false>(F, L, 0, inp(IMIXG) + L * DM, L == 0 ? inp(IX) : ((float*)(GAS float*)a.out), L == 0 ? inp(ICTX) : (const float*)(ws + WS_CTXS), true, nullptr); } SEAM(P + 0);
    RPT(2) if (EN(2) && IN(P + 1)) { SITE
        SchedIn S{G, cid, L, ws};
        pg8::gemm_phase(ring, F.wave, pg8::GemmK{DM, DM, DM}, S, EpiIn{ws, (float*)(ws + WS_SSQP) + (size_t)L * RT * 12});
    } SEAM(P + 1);
    RPT(4) if (EN(4) && IN(P + 2)) { SITE
        SchedPlain<72, 3, NC3, QL> S{G, cid, (const char*)(ws + DY_C), (const char*)(ws + WS_WUQ) + (size_t)L * 768 * QL * 2};
        pg8::gemm_phase(ring, F.wave, pg8::GemmK{NC3, QL, QL}, S, EpiUp<768, QL>{(bf16*)(ws + DY_Q), (const float*)(ws + WS_SSQP) + (size_t)L * RT * 12}); }
    RPT(17) if (EN(17) && IN(P + 2)) { SITE
        SchedPlain<72, 4, NC3, KVL, 40> S{G, cid, (const char*)(ws + DY_C) + C_CKV * 2, (const char*)(ws + WS_WUKV) + (size_t)L * 1024 * KVL * 2};
        pg8::gemm_phase(ring, F.wave, pg8::GemmK{NC3, KVL, KVL}, S, EpiUp<1024, KVL>{(bf16*)(ws + DY_KV), (const float*)(ws + WS_SSQP) + (size_t)L * RT * 12 + 8}); }
    if (L == 0) { RPT(16) if (EN(16) && IN(P + 2)) { SITE
        SchedDft<1, 512> S{G, (cid + 8) % G, (const char*)(ws + WS_DFTC), (const char*)(ws + DY_Z + 16 * MiB)};
        pg8::gemm_phase(ring, F.wave, pg8::GemmK{512, 512, 512}, S, EpiDft<CTXL>{(bf16*)(ws + DY_M) + (size_t)RX * DM + 768}); } }
    RPT(18) if (EN(18) && IN(P + 2)) { SITE conv_pass(F, inp(ICONVW) + L * CWID * CCH, inp(ICONVB) + L * CCH, inp(ICLNG) + L * CCH, inp(ICLNB) + L * CCH, 0); }
    RPT(15) if (EN(15) && IN(P + 2)) { SITE fft_stage_a(F); }
    SEAM(P + 2);
    if (EN(23) && IN(P + 3)) { SITE
        SchedFftC S{G, cid, (const char*)(ws + WS_DFTC), (const char*)(ws + DY_Z)};
        pg8::gemm_phase(ring, F.wave, pg8::GemmK{512, 4096, 512}, S, EpiFftC{(bf16*)(ws + DY_M) + 768}); }
    if (EN(5) && IN(P + 3)) { SITE t5_pass(F, inp(IQNG) + L * QKH, inp(IKNG) + L * QKH); } SEAM(P + 3);
    RPT(6) if (EN(6) && IN(P + 4)) { SITE
        const bf16* Q = (const bf16*)(ws + DY_Q); const bf16* K = (const bf16*)(ws + DY_K); const bf16* V = (const bf16*)(ws + DY_KV); bf16* O = (bf16*)(ws + DY_M);
        float mq, mk; { const int ln = lane_id(); const float* gq = inp(IQNG) + L * QKH; const float* gk = inp(IKNG) + L * QKH;
            float a = fmaxf(fabsf(gq[ln]), ln < 32 ? fabsf(gq[64 + ln]) : 0.f), b = fmaxf(fabsf(gk[ln]), ln < 32 ? fabsf(gk[64 + ln]) : 0.f);
#pragma unroll
            for (int o = 1; o < 64; o <<= 1) { a = fmaxf(a, __shfl_xor(a, o)); b = fmaxf(b, __shfl_xor(b, o)); }
            mq = __builtin_bit_cast(float, __builtin_amdgcn_readfirstlane(__builtin_bit_cast(int, a))); mk = __builtin_bit_cast(float, __builtin_amdgcn_readfirstlane(__builtin_bit_cast(int, b))); }
        const float B = 1.02f * 1.4426950408889634f * 9.797958971132712f * mq * mk; const bool fixed = B <= 60.0f; const float negB = fixed ? -B : 0.f;
        for (int u = cid; u < 512; u += G) { const int b = u >> 6, hh = (u >> 3) & 7, qb = u & 7; att::attn_unit(Q, K, V, O, b * SEQ + qb * 256, hh, 36, 32, b * SEQ, RX + b * CTXL, (LAS char*)ring, F.wave, negB, fixed, inp(IQNG) + L * QKH, (const float*)(ws + WS_ROPE) + (size_t)qb * 256 * 32); }
        if (L == 0) { for (int u = cid; u < 64; u += G) { const int b = u >> 3, hh = u & 7; att::attn_unit(Q, K, V, O, RX + b * CTXL, hh, 4, 0, 0, RX + b * CTXL, (LAS char*)ring, F.wave, negB, fixed, inp(IQNG) + L * QKH, nullptr); } }
    }
    SEAM(P + 4);
    if (EN(7) && IN(P + 5)) { SITE
        SchedResid<DM> S{G, cid, 0, L == 0 ? 72 : 64, (const char*)(ws + DY_M), (const char*)(ws + WS_WOUT) + (size_t)L * DM * DM * 2};
        EpiResid E{L == 0 ? inp(IX) : ((float*)(GAS float*)a.out), L == 0 ? inp(ICTX) : (const float*)(ws + WS_CTXS), ((float*)(GAS float*)a.out), (float*)(ws + WS_CTXS), modp(ws, L, 0, 2)};
        pg8::gemm_phase(ring, F.wave, pg8::GemmK{DM, DM, DM}, S, E);
    } SEAM(P + 5);
}
template <int K>
__device__ __forceinline__ void moe_round(const Args& a, Frame& F, const XcdBarrier& bar, const int lo, const int hi) {
    constexpr int rep_ = 0; (void)rep_;
    constexpr int P = K == 0 ? 18 : 21;
    LAS unsigned char* ring = F.lds;
    if (K == 0) { RPT(12) if (EN(12) && IN(P + 0)) { SITE moe_assign(F, 0); } SEAM(P + 0); }
    RPT(13) if (EN(13) && IN(P + 1)) { SITE
        SchedMoe<0> S{G, cid, (const int*)(ws + WS_MOE + MO_META) + 16 * K, ws};
        pg8::gemm_phase(ring, F.wave, pg8::GemmK{DM, DM, DM}, S, EpiPlain<DFF, true>{(bf16*)(ws + DY_ACT)});
    } SEAM(P + 1);
    if (EN(14) && IN(P + 2)) { SITE
        SchedMoe<2> S{G, cid, (const int*)(ws + WS_MOE + MO_META) + 16 * K, ws};
        EpiMoeDown E{(const int*)(ws + WS_MOE + MO_SROW) + K * 32768, (const float*)(ws + WS_MOE + MO_SW) + K * 32768, modp(ws, 1, 0, 5), ((float*)(GAS float*)a.out)};
        pg8::gemm_phase(ring, F.wave, pg8::GemmK{DFF, DFF, DFF}, S, E);
    }
    if (EN(19) && IN(P + 2)) { SITE
        SchedMoe<1> S{G, cid, (const int*)(ws + WS_MOE + MO_META) + 16 * K, ws};
        pg8::gemm_phase(ring, F.wave, pg8::GemmK{DM, DM, DM}, S, EpiPlain<DFF, true>{(bf16*)(ws + DY_ACT)});
    } SEAM(P + 2);
    if (EN(20) && IN(P + 3)) { SITE
        SchedMoe<3> S{G, cid, (const int*)(ws + WS_MOE + MO_META) + 16 * K, ws};
        EpiMoeDown E{(const int*)(ws + WS_MOE + MO_SROW) + K * 32768, (const float*)(ws + WS_MOE + MO_SW) + K * 32768, modp(ws, 1, 0, 5), ((float*)(GAS float*)a.out)};
        pg8::gemm_phase(ring, F.wave, pg8::GemmK{DFF, DFF, DFF}, S, E);
    }
    if (K == 0) { if (EN(12) && IN(P + 3)) { SITE moe_assign(F, 1); } }
    SEAM(P + 3);
}

__global__ void __launch_bounds__(512, 2) fwd(Args a) {
    extern __shared__ __attribute__((aligned(16))) unsigned char lds_raw[];
    Frame F;
    F.lds = (LAS unsigned char*)lds_raw; F.MISC = (volatile LAS unsigned*)(F.lds + MISC_OFF);
    F.wave = __builtin_amdgcn_readfirstlane((int)threadIdx.x >> 6);
    F.G = gridDim.x; F.gw = blockIdx.x * 8 + F.wave; F.NGW = F.G * 8; F.ws = a.ws; F.out = a.out;
    F.ctl = (gu32*)(a.ws + WS_CTL);
    for (int u = F.wave * 64 + lane_id(); u < (LDS_BYTES - LDSCTL_OFF) / 4; u += 512) ((LAS unsigned*)(F.lds + LDSCTL_OFF))[u] = 0u;
    __syncthreads();
    XcdBarrier bar; bar.bar = (unsigned*)(F.ctl + CW_BAR); bar.x = 0; bar.st = nullptr; bar.wave = F.wave;
    if (!MK_PER_PHASE) bar = xcd_barrier_post((unsigned*)(F.ctl + CW_BAR), F.MISC + 8, F.wave);
    const int lo = a.ph_lo, hi = a.ph_hi;
    LAS unsigned char* ring = F.lds;
    constexpr int rep_ = 0; (void)rep_;

    RPT(0) if (EN(0) && IN(0)) { if (PROBE_SITE >= 0 && rep_ > 0) xcd_barrier(bar); prologue(a, F); } SEAM(0);
    mixer_phases<0>(a, F, bar, lo, hi);
    RPT(8) if (EN(8) && IN(7)) { SITE adaln_pass<false>(F, 0, 3, inp(IFFNG), ((float*)(GAS float*)a.out), (const float*)(ws + WS_CTXS), true, nullptr); } SEAM(7);
    RPT(9) if (EN(9) && IN(8)) { SITE
        SchedGUa S{G, cid, (const char*)(ws + DY_H), (const char*)(ws + WS_WGU)};
        pg8::gemm_phase(ring, F.wave, pg8::GemmK{DM, DM, DM}, S, EpiPlain<DFF, true>{(bf16*)(ws + DY_ACT)});
    } SEAM(8);
    if (EN(10) && IN(9)) { SITE
        SchedResid<DFF> S{G, cid, 64, 8, (const char*)(ws + DY_ACT), (const char*)(ws + WS_WD)};
        EpiResid E{((float*)(GAS float*)a.out), (const float*)(ws + WS_CTXS), ((float*)(GAS float*)a.out), (float*)(ws + WS_CTXS), modp(ws, 0, 0, 5)};
        pg8::gemm_phase(ring, F.wave, pg8::GemmK{DFF, DFF, DFF}, S, E);
    }
    if (EN(21) && IN(9)) { SITE
        SchedGUb S{G, cid, (const char*)(ws + DY_H), (const char*)(ws + WS_WGU)};
        pg8::gemm_phase(ring, F.wave, pg8::GemmK{DM, DM, DM}, S, EpiPlain<DFF, true>{(bf16*)(ws + DY_ACT)});
    } SEAM(9);
    if (EN(22) && IN(10)) { SITE
        SchedResid<DFF> S{G, cid, 0, 64, (const char*)(ws + DY_ACT), (const char*)(ws + WS_WD)};
        EpiResid E{((float*)(GAS float*)a.out), (const float*)(ws + WS_CTXS), ((float*)(GAS float*)a.out), (float*)(ws + WS_CTXS), modp(ws, 0, 0, 5)};
        pg8::gemm_phase(ring, F.wave, pg8::GemmK{DFF, DFF, DFF}, S, E);
    } SEAM(10);
    mixer_phases<1>(a, F, bar, lo, hi);
    RPT(11) if (EN(11) && IN(17)) { SITE adaln_pass<true>(F, 1, 3, inp(IFFNG) + DM, ((float*)(GAS float*)a.out), nullptr, false, inp(IRW)); } SEAM(17);
    moe_round<0>(a, F, bar, lo, hi);
    moe_round<1>(a, F, bar, lo, hi);
}
#undef IN
#undef SEAM
#undef SITE

extern "C" void kernel_launch(void* const* d_in, const int* in_sizes, int n_in, void* d_out, int out_size, void* d_ws, size_t ws_size, hipStream_t stream) {
    static int grid = 0;
    if (grid == 0) {
        if (n_in != N_IN || out_size != RX * DM || ws_size < WS_END) { fprintf(stderr, "kernel_launch: unexpected shapes (n_in %d out %d ws %zu, need ws >= %zu)\n", n_in, out_size, ws_size, (size_t)WS_END); grid = -1; return; }
        int dev = 0, cus = 0, per_cu = 0;
        if (hipGetDevice(&dev) != hipSuccess || hipDeviceGetAttribute(&cus, hipDeviceAttributeMultiprocessorCount, dev) != hipSuccess) { grid = -1; return; }
        if (hipFuncSetAttribute((const void*)fwd, hipFuncAttributeMaxDynamicSharedMemorySize, LDS_BYTES) != hipSuccess) { fprintf(stderr, "kernel_launch: hipFuncSetAttribute failed\n"); grid = -1; return; }
        if (hipOccupancyMaxActiveBlocksPerMultiprocessor(&per_cu, (const void*)fwd, 512, LDS_BYTES) != hipSuccess || per_cu < 1) fprintf(stderr, "kernel_launch: occupancy query reports %d\n", per_cu);
        (void)hipGetLastError();
        grid = cus;
    }
    if (grid < 0) return;
    (void)hipMemsetAsync((char*)d_ws + WS_CTL, 0, CTL_ZERO_BYTES, stream);
    Args a{};
    for (int i = 0; i < N_IN; ++i) a.in[i] = (const float*)d_in[i];
    a.out = (float*)d_out; a.ws = (unsigned char*)d_ws;
#if MK_PER_PHASE
    for (int p = 0; p < N_PHASES; ++p) { a.ph_lo = p; a.ph_hi = p + 1; hipLaunchKernelGGL(fwd, dim3(grid), dim3(512), LDS_BYTES, stream, a); }
#else
    a.ph_lo = 0; a.ph_hi = N_PHASES;
    hipLaunchKernelGGL(fwd, dim3(grid), dim3(512), LDS_BYTES, stream, a);
#endif
}
```

```cpp
#include <hip/hip_runtime.h>
#include <cstdio>
#include <cstdint>

#ifndef MK_PER_PHASE
#define MK_PER_PHASE 0
#endif

#define GAS __attribute__((address_space(1)))
#define LAS __attribute__((address_space(3)))
typedef unsigned short bf16;
typedef short bf16x8 __attribute__((ext_vector_type(8)));
typedef short s16x4 __attribute__((ext_vector_type(4)));
typedef float f32x4 __attribute__((ext_vector_type(4)));
typedef float f32x2 __attribute__((ext_vector_type(2)));
typedef float f32x16 __attribute__((ext_vector_type(16)));
typedef unsigned u32x4 __attribute__((ext_vector_type(4)));
typedef unsigned u32x2 __attribute__((ext_vector_type(2)));
typedef GAS unsigned gu32;

constexpr int DM = 1024, NB = 8, SEQ = 2048, CTXL = 256, NH = 8, QKN = 64, QKR = 32, QKH = 96, VH = 64;
constexpr int QL = 384, KVL = 256, CCH = 256, CWID = 31, FCH = 256, INC = 1440, DFF = 2816, NE = 8;
constexpr int RX = NB * SEQ, RC = NB * CTXL, RT = RX + RC;
constexpr int OFF_CKV = 384, OFF_KR = 640, OFF_CONV = 672, OFF_FOUR = 1184;
constexpr int NCOL = 1280;
constexpr int NC3 = 768;
constexpr int C_KR = 384, C_CKV = 512;
constexpr float EPS = 1e-6f;
constexpr int NSLOT = RX + NE * 256;
constexpr int N_PHASES = 25;

constexpr size_t MiB = 1u << 20;
constexpr size_t WS_CTL = 0, CTL_ZERO_BYTES = 1 * MiB;
constexpr size_t WS_MOD = 1 * MiB;
constexpr size_t WS_ROPE = 2 * MiB;
constexpr size_t WS_MOE = 3 * MiB;
constexpr size_t WS_DFTC = 5 * MiB;
constexpr size_t WS_WUQ = 6 * MiB;
constexpr size_t WS_WUKV = 8 * MiB;
constexpr size_t WS_WIN = 10 * MiB;
constexpr size_t WS_WFT = 15 * MiB;
constexpr size_t WS_WOUT = 17 * MiB;
constexpr size_t WS_WGU = 21 * MiB;
constexpr size_t WS_WD = 32 * MiB;
constexpr size_t WS_SSQP = 38 * MiB;
constexpr size_t WS_MOEGU = 54 * MiB;
constexpr size_t WS_MOED = 142 * MiB;
constexpr size_t WS_CTXS = 186 * MiB;
constexpr size_t WS_DYN = 194 * MiB;
constexpr size_t DY_C = WS_DYN;
constexpr size_t DY_Z = DY_C + 45 * MiB;
constexpr size_t DY_Q = DY_Z + 18 * MiB;
constexpr size_t DY_KV = DY_Q + 27 * MiB;
constexpr size_t DY_M = DY_KV + 36 * MiB;
constexpr size_t DY_H = DY_M + 36 * MiB;
constexpr size_t WS_END = DY_H + 36 * MiB;
constexpr size_t DY_ACT = DY_C;
constexpr size_t DY_Y = DY_C + 27 * MiB, DY_K = DY_H;
static_assert(DY_ACT + (size_t)RT * DFF * 2 <= DY_M, "act overlay");
constexpr size_t MO_CNT = 0;
constexpr size_t MO_META = 64 * 1024;
constexpr size_t MO_TOKE = 128 * 1024;
constexpr size_t MO_TOKW = 256 * 1024;
constexpr size_t MO_SROW = 512 * 1024;
constexpr size_t MO_SW = 768 * 1024;

constexpr int CW_TMO = 0, CW_BAR = 4096;

constexpr int RING_BYTES = 131072;
constexpr int LDSCTL_OFF = RING_BYTES, MISC_OFF = LDSCTL_OFF + 320;
constexpr int LDS_BYTES = 147456;

#define RLX_AGENT __ATOMIC_RELAXED, __HIP_MEMORY_SCOPE_AGENT
#define LDS_WAIT() asm volatile("s_waitcnt lgkmcnt(0)" ::: "memory")
#define VM_WAIT() asm volatile("s_waitcnt vmcnt(0)" ::: "memory")
__device__ __forceinline__ unsigned f2bf(float f) { unsigned u = __builtin_bit_cast(unsigned, f); return (u + 0x7fffu + ((u >> 16) & 1u)) >> 16; }
__device__ __forceinline__ unsigned pk2(float lo, float hi) { return f2bf(lo) | (f2bf(hi) << 16); }
__device__ __forceinline__ float bflo(unsigned w) { return __builtin_bit_cast(float, w << 16); }
__device__ __forceinline__ float bfhi(unsigned w) { return __builtin_bit_cast(float, w & 0xffff0000u); }
__device__ __forceinline__ float bf1(bf16 v) { return __builtin_bit_cast(float, (unsigned)v << 16); }
__device__ __forceinline__ unsigned cvt_pk_bf16(float lo, float hi) { unsigned r; asm volatile("v_cvt_pk_bf16_f32 %0, %1, %2" : "=v"(r) : "v"(lo), "v"(hi)); return r; }
template <int CTRL> __device__ __forceinline__ float dpp_f(float v) { return __builtin_bit_cast(float, __builtin_amdgcn_update_dpp(0, __builtin_bit_cast(int, v), CTRL, 0xf, 0xf, true)); }
__device__ __forceinline__ float sum8(float v) {
    v += dpp_f<0xB1>(v);
    v += dpp_f<0x4E>(v);
    v += dpp_f<0x141>(v);
    return v;
}
__device__ __forceinline__ float wave_sum(float v) {
    v = sum8(v);
    v += dpp_f<0x140>(v);
    { auto r = __builtin_amdgcn_permlane16_swap(__float_as_uint(v), __float_as_uint(v), false, false); v = __uint_as_float(r[0]) + __uint_as_float(r[1]); }
    { auto r = __builtin_amdgcn_permlane32_swap(__float_as_uint(v), __float_as_uint(v), false, false); v = __uint_as_float(r[0]) + __uint_as_float(r[1]); }
    return v;
}
template <int CTRL> __device__ __forceinline__ int dpp_i(int v) { return __builtin_amdgcn_update_dpp(0, v, CTRL, 0xf, 0xf, true); }
__device__ __forceinline__ int wave_isum(int v) {
    v += dpp_i<0xB1>(v); v += dpp_i<0x4E>(v); v += dpp_i<0x141>(v); v += dpp_i<0x140>(v);
    { auto r = __builtin_amdgcn_permlane16_swap((unsigned)v, (unsigned)v, false, false); v = (int)(r[0] + r[1]); }
    { auto r = __builtin_amdgcn_permlane32_swap((unsigned)v, (unsigned)v, false, false); v = (int)(r[0] + r[1]); }
    return v;
}
__device__ __forceinline__ float sigmoidf_(float x) { return 1.0f / (1.0f + __expf(-x)); }
__device__ __forceinline__ float siluf_(float x) { return x / (1.0f + __expf(-x)); }

__device__ __forceinline__ int lane_id() { int l; asm volatile("v_mbcnt_lo_u32_b32 %0, -1, 0\n\tv_mbcnt_hi_u32_b32 %0, -1, %0" : "=v"(l)); return l; }
#define XB_TMO      128
#define XB_XCNT(j)  (256  + 64 * (j))
#define XB_XSUB(j)  (1280 + 64 * (j))
#define XB_XGEN(j)  (2304 + 64 * (j))
#define XB_TOP      3328
#define XB_TOPGEN   3392
#define XCD_BAR_WORDS 3456
#define XB_SPIN_CAP (1u << 18)
__device__ __forceinline__ unsigned xb_ld(unsigned* p)              { return __hip_atomic_load(p, __ATOMIC_RELAXED, __HIP_MEMORY_SCOPE_AGENT); }
__device__ __forceinline__ unsigned xb_add(unsigned* p, unsigned v) { return __hip_atomic_fetch_add(p, v, __ATOMIC_RELAXED, __HIP_MEMORY_SCOPE_AGENT); }
__device__ __forceinline__ unsigned xb_xcc_id() { return (unsigned)__builtin_amdgcn_s_getreg((3 << 11) | 20) & 0xFu; }
#define XB_SPIN(cond, bar) do { unsigned _sp = 0; while (cond) { __builtin_amdgcn_s_sleep(1); \
    if ((++_sp & 255u) == 0u) { if (xb_ld(&(bar)[XB_TMO])) break; if (_sp > XB_SPIN_CAP) { atomicAdd(&(bar)[XB_TMO], 1u); break; } } } } while (0)
struct XcdBarrier { unsigned* bar; unsigned x; volatile LAS unsigned* st; int wave; };
__device__ __forceinline__ XcdBarrier xcd_barrier_post(unsigned* bar, volatile LAS unsigned* st, int wave) {
    XcdBarrier b; b.bar = bar; b.x = xb_xcc_id(); b.st = st; b.wave = wave;
    if (wave == 0 && lane_id() == 0) (void)xb_add(&bar[XB_XCNT(b.x)], 1u);
    return b;
}
__device__ __forceinline__ void xcd_barrier_complete(unsigned* bar, unsigned x, unsigned& nloc, unsigned& nx) {
    const unsigned G = gridDim.x * gridDim.y * gridDim.z;
    unsigned sum, cnt, mine, sp = 0u;
    for (;;) {
        sum = 0u; cnt = 0u; mine = 0u;
#pragma nounroll
        for (unsigned j = 0; j < 16; ++j) { const unsigned c = xb_ld(&bar[XB_XCNT(j)]); sum += c; cnt += (c > 0u) ? 1u : 0u; mine = (j == x) ? c : mine; }
        if (sum == G) break;
        __builtin_amdgcn_s_sleep(1);
        if ((++sp & 255u) == 0u) { if (xb_ld(&bar[XB_TMO])) break; if (sp > XB_SPIN_CAP) { atomicAdd(&bar[XB_TMO], 1u); break; } }
    }
    nloc = mine > 0u ? mine : 1u; nx = cnt > 0u ? cnt : 1u;
}
__device__ __forceinline__ void xcd_barrier(const XcdBarrier& b) {
    asm volatile("s_waitcnt vmcnt(0)" ::: "memory");
    __syncthreads();
    if (b.wave == 0 && lane_id() == 0) {
        unsigned* bar = b.bar;
        __builtin_amdgcn_s_waitcnt(0);
        unsigned nloc = b.st[0], nx = b.st[1];
        if (nloc == 0u) { xcd_barrier_complete(bar, b.x, nloc, nx); b.st[0] = nloc; b.st[1] = nx; }
        const unsigned old = xb_add(&bar[XB_XSUB(b.x)], 1u);
        const unsigned gen = old / nloc;
        if (old + 1u == (gen + 1u) * nloc) {
            __builtin_amdgcn_fence(__ATOMIC_RELEASE, "agent");
            asm volatile("s_waitcnt vmcnt(0)" ::: "memory");
            const unsigned og = xb_add(&bar[XB_TOP], 1u);
            const unsigned tg = og / nx;
            if (og + 1u == (tg + 1u) * nx) xb_add(&bar[XB_TOPGEN], 1u);
            else XB_SPIN(xb_ld(&bar[XB_TOPGEN]) == tg, bar);
            __builtin_amdgcn_fence(__ATOMIC_ACQUIRE, "agent");
            xb_add(&bar[XB_XGEN(b.x)], 1u);
            asm volatile("s_waitcnt vmcnt(0)" ::: "memory");
        } else {
            XB_SPIN(xb_ld(&bar[XB_XGEN(b.x)]) == gen, bar);
            __builtin_amdgcn_fence(__ATOMIC_ACQUIRE, "agent");
            asm volatile("s_waitcnt vmcnt(0)" ::: "memory");
        }
    }
    __syncthreads();
}

namespace pg8 {
constexpr int BM = 256, BK = 64, HALF = 128, HTB = HALF * BK * 2, STAGE_BYTES = 8 * HTB;
__host__ __device__ __forceinline__ int lds_byte(int r, int c) { const int st = (r >> 4) * 2 + (c >> 5), rr = r & 15, cc = c & 31, ob = rr * 64 + cc * 2; return st * 1024 + (ob ^ (((ob >> 9) & 1) << 5)); }
__host__ __device__ __forceinline__ void stage_rc(int b, int& R, int& C) { const int st = b / 1024, sb = b % 1024, swz = sb ^ (((sb >> 9) & 1) << 5); R = (st >> 1) * 16 + swz / 64; C = (st & 1) * 32 + (swz % 64) / 2; }
__host__ __device__ __forceinline__ int perm32(int rho) { const int n = rho >> 4, i = rho & 15; return 8 * (i >> 2) + 4 * n + (i & 3); }

struct Unit { int pm, pn; };
struct GemmK { int lda, ldb, K; };

__device__ __forceinline__ void store_tile_bf16(const f32x4 (&acc)[2][2][4][2], bf16* C, int ldc, int wr, int wc, int fr, int fq) {
    const unsigned off0 = (unsigned)((wr * 64 + fr) * ldc + wc * 32 + 8 * fq) * 2u;
#pragma unroll
    for (int ai = 0; ai < 2; ++ai)
#pragma unroll
        for (int m = 0; m < 4; ++m) { const unsigned offr = off0 + (unsigned)((ai * HALF + m * 16) * ldc) * 2u;
#pragma unroll
            for (int bj = 0; bj < 2; ++bj) { const f32x4 v0 = acc[ai][bj][m][0], v1 = acc[ai][bj][m][1];
                u32x4 w; w.x = cvt_pk_bf16(v0[0], v0[1]); w.y = cvt_pk_bf16(v0[2], v0[3]); w.z = cvt_pk_bf16(v1[0], v1[1]); w.w = cvt_pk_bf16(v1[2], v1[3]);
                *(u32x4*)((char*)C + (offr + (unsigned)(bj * HALF * 2))) = w; } }
}
__device__ __forceinline__ void store_tile_swiglu(const f32x4 (&acc)[2][2][4][2], bf16* C, int ldc, int wr, int wc, int fr, int fq) {
    const unsigned off0 = (unsigned)((wr * 64 + fr) * ldc + wc * 32 + 8 * fq) * 2u;
#pragma unroll
    for (int ai = 0; ai < 2; ++ai)
#pragma unroll
        for (int m = 0; m < 4; ++m) { const unsigned offr = off0 + (unsigned)((ai * HALF + m * 16) * ldc) * 2u;
            float o[8];
#pragma unroll
            for (int n = 0; n < 2; ++n)
#pragma unroll
                for (int e = 0; e < 4; ++e) { const float g = acc[ai][0][m][n][e], up = acc[ai][1][m][n][e]; o[n * 4 + e] = g * __builtin_amdgcn_rcpf(1.0f + __expf(-g)) * up; }
            u32x4 w; w.x = cvt_pk_bf16(o[0], o[1]); w.y = cvt_pk_bf16(o[2], o[3]); w.z = cvt_pk_bf16(o[4], o[5]); w.w = cvt_pk_bf16(o[6], o[7]);
            *(u32x4*)((char*)C + offr) = w; }
}
__device__ __forceinline__ void store_tile_resid(const f32x4 (&acc)[2][2][4][2], const float* X, float* C, const float* gvp, int wr, int wc, int fr, int fq) {
    const int col0 = wc * 32 + 4 * fq;
    f32x4 gv[2][2];
#pragma unroll
    for (int bj = 0; bj < 2; ++bj)
#pragma unroll
        for (int n = 0; n < 2; ++n) gv[bj][n] = *(const f32x4*)((const char*)gvp + (unsigned)(col0 + bj * HALF + n * 16) * 4u);
    const unsigned off0 = (unsigned)((wr * 64 + fr) * DM + col0) * 4u;
#pragma unroll
    for (int ai = 0; ai < 2; ++ai)
#pragma unroll
        for (int m = 0; m < 4; ++m) { const unsigned offr = off0 + (unsigned)((ai * HALF + m * 16) * DM) * 4u;
#pragma unroll
            for (int bj = 0; bj < 2; ++bj)
#pragma unroll
                for (int n = 0; n < 2; ++n) { const unsigned o = offr + (unsigned)(bj * HALF + n * 16) * 4u; const f32x4 xv = *(const f32x4*)((const char*)X + o); *(f32x4*)((char*)C + o) = xv + gv[bj][n] * acc[ai][bj][m][n]; } }
}

template <int NP>
__device__ __forceinline__ void store_tile_bf16_rs(const f32x4 (&acc)[2][2][4][2], bf16* C, int ldc, const float* part, float inv_k, int wr, int wc, int fr, int fq) {
    const unsigned off0 = (unsigned)((wr * 64 + fr) * ldc + wc * 32 + 8 * fq) * 2u;
#pragma unroll
    for (int ai = 0; ai < 2; ++ai)
#pragma unroll
        for (int m = 0; m < 4; ++m) { const unsigned offr = off0 + (unsigned)((ai * HALF + m * 16) * ldc) * 2u;
            const float* pr = part + (size_t)(ai * HALF + wr * 64 + m * 16 + fr) * 12; float ss;
            { const f32x4 p0 = *(const f32x4*)pr; ss = (p0.x + p0.y) + (p0.z + p0.w); if (NP == 8) { const f32x4 p1 = *(const f32x4*)(pr + 4); ss += (p1.x + p1.y) + (p1.z + p1.w); } }
            const float rs = 1.0f / sqrtf(ss * inv_k + EPS);
#pragma unroll
            for (int bj = 0; bj < 2; ++bj) { const f32x4 v0 = acc[ai][bj][m][0] * rs, v1 = acc[ai][bj][m][1] * rs;
                u32x4 w; w.x = cvt_pk_bf16(v0[0], v0[1]); w.y = cvt_pk_bf16(v0[2], v0[3]); w.z = cvt_pk_bf16(v1[0], v1[1]); w.w = cvt_pk_bf16(v1[2], v1[3]);
                *(u32x4*)((char*)C + (offr + (unsigned)(bj * HALF * 2))) = w; } }
}
template <int NBJ>
__device__ __forceinline__ void store_tile_bf16_ssq(const f32x4 (&acc)[2][2][4][2], bf16* C, int ldc, float* part, int wr, int wc, int fr, int fq) {
    const unsigned off0 = (unsigned)((wr * 64 + fr) * ldc + wc * 32 + 8 * fq) * 2u;
#pragma unroll
    for (int ai = 0; ai < 2; ++ai)
#pragma unroll
        for (int m = 0; m < 4; ++m) { const unsigned offr = off0 + (unsigned)((ai * HALF + m * 16) * ldc) * 2u; float sq = 0.f;
#pragma unroll
            for (int bj = 0; bj < 2; ++bj) { const f32x4 v0 = acc[ai][bj][m][0], v1 = acc[ai][bj][m][1];
                u32x4 w; w.x = cvt_pk_bf16(v0[0], v0[1]); w.y = cvt_pk_bf16(v0[2], v0[3]); w.z = cvt_pk_bf16(v1[0], v1[1]); w.w = cvt_pk_bf16(v1[2], v1[3]);
                *(u32x4*)((char*)C + (offr + (unsigned)(bj * HALF * 2))) = w;
                if (bj < NBJ) { float a;
                    a = bflo(w.x); sq += a * a; a = bfhi(w.x); sq += a * a; a = bflo(w.y); sq += a * a; a = bfhi(w.y); sq += a * a;
                    a = bflo(w.z); sq += a * a; a = bfhi(w.z); sq += a * a; a = bflo(w.w); sq += a * a; a = bfhi(w.w); sq += a * a; } }
            { auto r = __builtin_amdgcn_permlane16_swap(__float_as_uint(sq), __float_as_uint(sq), false, false); sq = __uint_as_float(r[0]) + __uint_as_float(r[1]); }
            { auto r = __builtin_amdgcn_permlane32_swap(__float_as_uint(sq), __float_as_uint(sq), false, false); sq = __uint_as_float(r[0]) + __uint_as_float(r[1]); }
            if (fq == 0) part[(size_t)(ai * HALF + wr * 64 + m * 16 + fr) * 12] = sq; }
}
__device__ __forceinline__ void store_tile_glu(const f32x4 (&acc)[2][2][4][2], bf16* C, int ldc, int wr, int wc, int fr, int fq) {
    const unsigned off0 = (unsigned)((wr * 64 + fr) * ldc + wc * 32 + 8 * fq) * 2u;
#pragma unroll
    for (int ai = 0; ai < 2; ++ai)
#pragma unroll
        for (int m = 0; m < 4; ++m) { const unsigned offr = off0 + (unsigned)((ai * HALF + m * 16) * ldc) * 2u;
            float o[8];
#pragma unroll
            for (int n = 0; n < 2; ++n)
#pragma unroll
                for (int e = 0; e < 4; ++e) { const float av = acc[ai][0][m][n][e], g = acc[ai][1][m][n][e]; o[n * 4 + e] = av * __builtin_amdgcn_rcpf(1.0f + __expf(-g)); }
            u32x4 w; w.x = cvt_pk_bf16(o[0], o[1]); w.y = cvt_pk_bf16(o[2], o[3]); w.z = cvt_pk_bf16(o[4], o[5]); w.w = cvt_pk_bf16(o[6], o[7]);
            *(u32x4*)((char*)C + offr) = w; }
}

template <class Epi, class Sched>
__device__ __forceinline__ void gemm_phase(LAS unsigned char* lds, const int wave, const GemmK g, const Sched& S, const Epi& E) {
    int tid = wave * 64 + lane_id(); asm volatile("" : "+v"(tid));
    const int wid = wave, lane = tid & 63, wr = wid >> 2, wc = wid & 3, fr = lane & 15, fq = lane >> 4;
    const int nt = g.K / BK;
    unsigned voffA[2], voffB[2];
#pragma unroll
    for (int i = 0; i < 2; ++i) { int R, C; stage_rc(tid * 16 + i * 8192, R, C); const int Rb = Epi::PERM ? ((R & ~31) + perm32(R & 31)) : R;
        voffA[i] = (unsigned)(R * g.lda + C) * 2u; voffB[i] = (unsigned)(Rb * g.ldb + C) * 2u; }
    const size_t kstep = (size_t)(BK * 2);
    const size_t hsA = (size_t)HALF * g.lda * 2, hsB = (size_t)HALF * g.ldb * 2;
    const unsigned ldsw = (unsigned)wid * 1024u;
    const int aoff = lds_byte(wr * 64 + fr, fq * 8), boff = lds_byte(wc * 32 + fr, fq * 8);
#define PG8_SA(b, h) (((b) * 2 + (h)) * HTB)
#define PG8_SB(b, h) ((4 + (b) * 2 + (h)) * HTB)
#define PG8_STAGE(bufoff, gbase, voff) do { _Pragma("unroll") for (int _i = 0; _i < 2; ++_i) \
        __builtin_amdgcn_global_load_lds((const unsigned*)((const char*)(gbase) + (voff)[_i]), (LAS unsigned*)(lds + (bufoff) + ldsw + _i * 8192), 16, 0, 0); } while (0)
#define PG8_LDA(dst, b, h) do { _Pragma("unroll") for (int m = 0; m < 4; ++m) _Pragma("unroll") for (int k = 0; k < 2; ++k) dst[m][k] = *(const LAS bf16x8*)(lds + PG8_SA(b, h) + aoff + m * 2048 + k * 1024); } while (0)
#define PG8_LDB(dst, b, h) do { _Pragma("unroll") for (int n = 0; n < 2; ++n) _Pragma("unroll") for (int k = 0; k < 2; ++k) dst[n][k] = *(const LAS bf16x8*)(lds + PG8_SB(b, h) + boff + n * 2048 + k * 1024); } while (0)
#define PG8_MMA(ai, bj, At, Bt) do { __builtin_amdgcn_s_setprio(1); _Pragma("unroll") for (int m = 0; m < 4; ++m) _Pragma("unroll") for (int n = 0; n < 2; ++n) _Pragma("unroll") for (int k = 0; k < 2; ++k) \
        acc[ai][bj][m][n] = __builtin_amdgcn_mfma_f32_16x16x32_bf16(Bt[n][k], At[m][k], acc[ai][bj][m][n], 0, 0, 0); __builtin_amdgcn_s_setprio(0); } while (0)
#define PG8_WAIT_V(n) asm volatile("s_waitcnt vmcnt(" #n ")" ::: "memory")
#define PG8_WAIT_L(n) asm volatile("s_waitcnt lgkmcnt(" #n ")" ::: "memory")
#define PG8_BAR __builtin_amdgcn_s_barrier()
#define PG8_SCHED __builtin_amdgcn_sched_barrier(0)
    Unit cur, nxt; int ui = 0;
    if (!S.next(0, cur)) return;
    f32x4 acc[2][2][4][2];
#pragma unroll
    for (int a = 0; a < 2; ++a)
#pragma unroll
        for (int b = 0; b < 2; ++b)
#pragma unroll
            for (int m = 0; m < 4; ++m)
#pragma unroll
                for (int n = 0; n < 2; ++n) acc[a][b][m][n] = (f32x4){0.f, 0.f, 0.f, 0.f};
    bf16x8 At[4][2], B0[2][2], B1[2][2];
    const char* cA = S.aptr(cur); const char* cB = S.bptr(cur);
    PG8_STAGE(PG8_SB(0, 0), cB, voffB); PG8_STAGE(PG8_SB(0, 1), cB + hsB, voffB); PG8_STAGE(PG8_SA(0, 0), cA, voffA); PG8_STAGE(PG8_SA(0, 1), cA + hsA, voffA);
    if (wr == 1) PG8_BAR;
    PG8_WAIT_V(2); PG8_BAR;
    PG8_STAGE(PG8_SB(1, 0), cB + kstep, voffB); PG8_STAGE(PG8_SA(1, 0), cA + kstep, voffA); PG8_STAGE(PG8_SB(1, 1), cB + hsB + kstep, voffB);
    PG8_WAIT_V(6); PG8_BAR;
    for (;;) {
        const bool has_next = S.next(ui + 1, nxt);
        const char* nA = has_next ? S.aptr(nxt) : cA; const char* nB = has_next ? S.bptr(nxt) : cB;
#pragma nounroll
        for (int t = 0; t < nt; t += 2) {
            const bool last = (t == nt - 2);
            const char* a1 = cA + (size_t)(t + 1) * kstep;
            const char* a2 = last ? nA : cA + (size_t)(t + 2) * kstep; const char* b2 = last ? nB : cB + (size_t)(t + 2) * kstep;
            const char* a3 = a2 + kstep; const char* b3 = b2 + kstep;
            PG8_LDB(B0, 0, 0); PG8_LDB(B1, 0, 1); PG8_SCHED; PG8_LDA(At, 0, 0); PG8_STAGE(PG8_SA(1, 1), a1 + hsA, voffA);
            PG8_WAIT_V(8); PG8_WAIT_L(0); PG8_BAR; PG8_MMA(0, 0, At, B0); PG8_MMA(0, 1, At, B1); PG8_BAR; PG8_SCHED;
            PG8_LDA(At, 0, 1); PG8_STAGE(PG8_SB(0, 0), b2, voffB); PG8_STAGE(PG8_SB(0, 1), b2 + hsB, voffB); PG8_STAGE(PG8_SA(0, 0), a2, voffA);
            PG8_WAIT_V(8); PG8_WAIT_L(0); PG8_BAR; PG8_MMA(1, 0, At, B0); PG8_MMA(1, 1, At, B1); PG8_BAR; PG8_SCHED;
            PG8_LDB(B0, 1, 0); PG8_LDB(B1, 1, 1); PG8_SCHED; PG8_LDA(At, 1, 0); PG8_STAGE(PG8_SA(0, 1), a2 + hsA, voffA);
            PG8_WAIT_V(8); PG8_WAIT_L(0); PG8_BAR; PG8_MMA(0, 0, At, B0); PG8_MMA(0, 1, At, B1); PG8_BAR; PG8_SCHED;
            PG8_LDA(At, 1, 1); PG8_STAGE(PG8_SB(1, 0), b3, voffB); PG8_STAGE(PG8_SB(1, 1), b3 + hsB, voffB); PG8_STAGE(PG8_SA(1, 0), a3, voffA);
            PG8_WAIT_V(8); PG8_WAIT_L(0); PG8_BAR; PG8_MMA(1, 0, At, B0); PG8_MMA(1, 1, At, B1); PG8_BAR; PG8_SCHED;
        }
        if (wr == 0) PG8_BAR;
        { int fr_ = fr, fq_ = fq; asm volatile("" : "+v"(fr_), "+v"(fq_));
          E(acc, cur, wr, wc, fr_, fq_); }
        if (!has_next) break;
#pragma unroll
        for (int a = 0; a < 2; ++a)
#pragma unroll
            for (int b = 0; b < 2; ++b)
#pragma unroll
                for (int m = 0; m < 4; ++m)
#pragma unroll
                    for (int n = 0; n < 2; ++n) acc[a][b][m][n] = (f32x4){0.f, 0.f, 0.f, 0.f};
        cur = nxt; cA = nA; cB = nB; ++ui;
        if (wr == 1) PG8_BAR;
    }
    PG8_WAIT_V(0);
    PG8_BAR;
#undef PG8_SA
#undef PG8_SB
#undef PG8_STAGE
#undef PG8_LDA
#undef PG8_LDB
#undef PG8_MMA
#undef PG8_WAIT_V
#undef PG8_WAIT_L
#undef PG8_BAR
#undef PG8_SCHED
}
}

namespace att {
constexpr int SHM_V = 64 * 64 * 2, SHM_K = 64 * 256;
constexpr int NSLOT = 3;
constexpr int LDS_V = 0, LDS_K = NSLOT * SHM_V, LDS_WS = NSLOT * SHM_V + NSLOT * SHM_K, LDS_TOTAL = LDS_WS + 8 * 64 * 4;
constexpr float THR2 = 11.5f;
#define KSWZ(row, colB) ((row) * 256 + ((colB) ^ (((row) & 7) << 4)))
#define SBAR() __builtin_amdgcn_sched_barrier(0)
__device__ __forceinline__ int crow(int r, int hi) { return (r & 3) + 8 * (r >> 2) + 4 * hi; }
__device__ __forceinline__ int v_st(int k, int c) { const int kk = (k & ~0xC) | ((k & 4) << 1) | ((k & 8) >> 1); return ((kk >> 3) * 2 + (c >> 5)) * 512 + ((kk & 7) * 32 + (c & 31)) * 2; }
__device__ __forceinline__ int v_rd_base(int lane) { return ((lane & 3) << 3) | (((lane >> 2) & 3) << 6) | (((lane >> 4) & 1) << 5) | (((lane >> 5) & 1) << 8); }
constexpr int v_rd_off(int d0, int ks, int half) { return d0 * 512 + ks * 2048 + half * 1024; }
template <int OFF> __device__ __forceinline__ s16x4 tr_read(int vb) {
    s16x4 r; asm volatile("ds_read_b64_tr_b16 %0, %1 offset:%2" : "=&v"(r) : "v"(vb), "i"(OFF) : "memory"); return r;
}
__device__ __forceinline__ void partialSM(f32x16& p0, f32x16& p1, float& m_reg, float& mn, float& alpha, const bool fixed) {
    if (!fixed) {
        float pmax = p0[0];
#pragma unroll
        for (int r = 1; r < 16; ++r) pmax = fmaxf(pmax, p0[r]);
#pragma unroll
        for (int r = 0; r < 16; ++r) pmax = fmaxf(pmax, p1[r]);
        { auto rr = __builtin_amdgcn_permlane32_swap(__float_as_uint(pmax), __float_as_uint(pmax), false, false);
          pmax = fmaxf(__uint_as_float(rr[0]), __uint_as_float(rr[1])); }
        if (__builtin_expect(__all(pmax - m_reg <= THR2), 1)) { mn = m_reg; alpha = 1.f; }
        else { mn = fmaxf(m_reg, pmax); alpha = __builtin_amdgcn_exp2f(m_reg - mn); m_reg = mn; }
#pragma unroll
        for (int r = 0; r < 16; ++r) p0[r] = p0[r] - mn;
#pragma unroll
        for (int r = 0; r < 16; ++r) p1[r] = p1[r] - mn;
    } else { mn = 0.f; alpha = 1.f; }
#pragma unroll
    for (int r = 0; r < 16; ++r) p0[r] = __builtin_amdgcn_exp2f(p0[r]);
}
__device__ __forceinline__ void finishSM(f32x16& p0, f32x16& p1, float alpha, float& l_reg, bf16x8& pa0, bf16x8& pa1, bf16x8& pa2, bf16x8& pa3) {
#pragma unroll
    for (int r = 0; r < 16; ++r) p1[r] = __builtin_amdgcn_exp2f(p1[r]);
    float ps = 0;
#pragma unroll
    for (int r = 0; r < 16; ++r) ps += p0[r];
#pragma unroll
    for (int r = 0; r < 16; ++r) ps += p1[r];
    { auto rr = __builtin_amdgcn_permlane32_swap(__float_as_uint(ps), __float_as_uint(ps), false, false);
      ps = __uint_as_float(rr[0]) + __uint_as_float(rr[1]); }
    l_reg = l_reg * alpha + ps;
#define PK4(P, BASE, OUT) do { unsigned a0 = cvt_pk_bf16(P[BASE + 0], P[BASE + 1]), a1 = cvt_pk_bf16(P[BASE + 2], P[BASE + 3]);   \
    unsigned b0 = cvt_pk_bf16(P[BASE + 4], P[BASE + 5]), b1 = cvt_pk_bf16(P[BASE + 6], P[BASE + 7]);                              \
    auto r0 = __builtin_amdgcn_permlane32_swap(a0, b0, false, false); auto r1 = __builtin_amdgcn_permlane32_swap(a1, b1, false, false); \
    u32x4 w = {r0[0], r1[0], r0[1], r1[1]}; OUT = __builtin_bit_cast(bf16x8, w); } while (0)
    PK4(p0, 0, pa0); PK4(p0, 8, pa1); PK4(p1, 0, pa2); PK4(p1, 8, pa3);
#undef PK4
}
__device__ __forceinline__ void qkt(f32x16& p0, f32x16& p1, const LAS char* Ks, const bf16x8* qr, int r32, int hi, const float c0) {
#pragma unroll
    for (int r = 0; r < 16; ++r) { p0[r] = c0; p1[r] = c0; }
#pragma unroll
    for (int d0 = 0; d0 < 6; ++d0) { const int cb = (d0 * 16 + hi * 8) * 2;
        const bf16x8 b0 = *(const LAS bf16x8*)(Ks + KSWZ(r32, cb));
        const bf16x8 b1 = *(const LAS bf16x8*)(Ks + KSWZ(32 + r32, cb));
        p0 = __builtin_amdgcn_mfma_f32_32x32x16_bf16(b0, qr[d0], p0, 0, 0, 0);
        p1 = __builtin_amdgcn_mfma_f32_32x32x16_bf16(b1, qr[d0], p1, 0, 0, 0); }
}
template <int D0> __device__ __forceinline__ void pv_one(f32x16& od, int vb, bf16x8 pa0, bf16x8 pa1, bf16x8 pa2, bf16x8 pa3) {
    const s16x4 l0 = tr_read<v_rd_off(D0, 0, 0)>(vb), h0 = tr_read<v_rd_off(D0, 0, 1)>(vb), l1 = tr_read<v_rd_off(D0, 1, 0)>(vb), h1 = tr_read<v_rd_off(D0, 1, 1)>(vb);
    const s16x4 l2 = tr_read<v_rd_off(D0, 2, 0)>(vb), h2 = tr_read<v_rd_off(D0, 2, 1)>(vb), l3 = tr_read<v_rd_off(D0, 3, 0)>(vb), h3 = tr_read<v_rd_off(D0, 3, 1)>(vb);
    asm volatile("s_waitcnt lgkmcnt(0)" ::: "memory"); SBAR();
#define PKV(L, H) (bf16x8){L[0], L[1], L[2], L[3], H[0], H[1], H[2], H[3]}
    od = __builtin_amdgcn_mfma_f32_32x32x16_bf16(pa0, PKV(l0, h0), od, 0, 0, 0);
    od = __builtin_amdgcn_mfma_f32_32x32x16_bf16(pa1, PKV(l1, h1), od, 0, 0, 0);
    od = __builtin_amdgcn_mfma_f32_32x32x16_bf16(pa2, PKV(l2, h2), od, 0, 0, 0);
    od = __builtin_amdgcn_mfma_f32_32x32x16_bf16(pa3, PKV(l3, h3), od, 0, 0, 0);
#undef PKV
}
__device__ __forceinline__ void pv_all(f32x16* o, int vb, bf16x8 pa0, bf16x8 pa1, bf16x8 pa2, bf16x8 pa3) {
    pv_one<0>(o[0], vb, pa0, pa1, pa2, pa3); pv_one<1>(o[1], vb, pa0, pa1, pa2, pa3);
}
__device__ __forceinline__ void attn_unit(const bf16* __restrict__ Q, const bf16* __restrict__ K, const bf16* __restrict__ V, bf16* __restrict__ O,
                                          int qrow0, int h, int NT, int nx, int kx0, int kc0, LAS char* lds, const int wave, const float negB, const bool fixed, const float* qgain, const float* qrope) {
    int tid = wave * 64 + lane_id(); asm volatile("" : "+v"(tid));
    const int wid = wave, lane = tid & 63, r32 = lane & 31, hi = lane >> 5;
    LAS char* V_lds = lds + LDS_V; LAS char* K_lds = lds + LDS_K;
    LAS float* ws = (LAS float*)(lds + LDS_WS) + wid * 64; LAS float* li_l = ws; LAS float* al_l = ws + 32;
    float m_reg = -1e30f, l_reg = 0; f32x16 o[2]; o[0] = f32x16{}; o[1] = f32x16{}; bf16x8 qr[6];
    const bf16* Qw = Q + (size_t)(qrow0 + wid * 32 + r32) * 768 + h * 96 + hi * 8;
#pragma unroll
    for (int d0 = 0; d0 < 6; ++d0) qr[d0] = *(const bf16x8*)(Qw + d0 * 16);
    {
        float qf[6][8]; float ss = 0.f;
#pragma unroll
        for (int d0 = 0; d0 < 6; ++d0) { const u32x4 w = __builtin_bit_cast(u32x4, qr[d0]);
            qf[d0][0] = bflo(w.x); qf[d0][1] = bfhi(w.x); qf[d0][2] = bflo(w.y); qf[d0][3] = bfhi(w.y); qf[d0][4] = bflo(w.z); qf[d0][5] = bfhi(w.z); qf[d0][6] = bflo(w.w); qf[d0][7] = bfhi(w.w);
#pragma unroll
            for (int j = 0; j < 8; ++j) ss += qf[d0][j] * qf[d0][j]; }
        { auto rr = __builtin_amdgcn_permlane32_swap(__float_as_uint(ss), __float_as_uint(ss), false, false); ss = __uint_as_float(rr[0]) + __uint_as_float(rr[1]); }
        const float rinv = (1.0f / sqrtf(ss * (1.0f / QKH) + EPS)) * (0.10206207261596577f * 1.4426950408889634f);
#pragma unroll
        for (int d0 = 0; d0 < 6; ++d0) { const f32x4 g0 = *(const f32x4*)(qgain + d0 * 16 + hi * 8), g1 = *(const f32x4*)(qgain + d0 * 16 + hi * 8 + 4);
#pragma unroll
            for (int j = 0; j < 4; ++j) { qf[d0][j] *= rinv * g0[j]; qf[d0][4 + j] *= rinv * g1[j]; } }
        if (qrope) { const float* rp = qrope + (size_t)(wid * 32 + r32) * 32 + hi * 8;
            const f32x4 c0 = *(const f32x4*)rp, c1 = *(const f32x4*)(rp + 4), s0 = *(const f32x4*)(rp + 16), s1 = *(const f32x4*)(rp + 20);
#pragma unroll
            for (int j = 0; j < 8; ++j) { const float c = j < 4 ? c0[j & 3] : c1[j & 3], sn = j < 4 ? s0[j & 3] : s1[j & 3]; const float x1 = qf[4][j], x2 = qf[5][j]; qf[4][j] = x1 * c - x2 * sn; qf[5][j] = x2 * c + x1 * sn; } }
#pragma unroll
        for (int d0 = 0; d0 < 6; ++d0) { u32x4 w; w.x = pk2(qf[d0][0], qf[d0][1]); w.y = pk2(qf[d0][2], qf[d0][3]); w.z = pk2(qf[d0][4], qf[d0][5]); w.w = pk2(qf[d0][6], qf[d0][7]); qr[d0] = __builtin_bit_cast(bf16x8, w); }
    }
    const int vr = tid >> 3, vc = tid & 7, vst = v_st(vr, vc * 8);
    const int kr0 = tid / 12, kc0_ = tid % 12, kr1 = (tid + 512) / 12, kc1_ = (tid + 512) % 12; const bool k2 = tid < 256;
    const int kst0 = KSWZ(kr0, kc0_ * 16), kst1 = KSWZ(kr1, kc1_ * 16);
    const bf16* Kh = K + h * 96; const bf16* Vh = V + h * 128 + 64;
    const int vb0 = (int)(uintptr_t)V_lds + v_rd_base(lane);
    struct { bf16x8 vs, ks0, ks1; } sr_[2];
#define TROW(j) ((j) < nx ? kx0 + (j) * 64 : kc0 + ((j) - nx) * 64)
#define SLOAD(i, j) do { const int t0_ = TROW(j); sr_[i].vs = *(const bf16x8*)(Vh + (size_t)(t0_ + vr) * 1024 + vc * 8); \
    sr_[i].ks0 = *(const bf16x8*)(Kh + (size_t)(t0_ + kr0) * 768 + kc0_ * 8); if (k2) sr_[i].ks1 = *(const bf16x8*)(Kh + (size_t)(t0_ + kr1) * 768 + kc1_ * 8); } while (0)
#define SWRITE(slot, i) do { *(LAS bf16x8*)(V_lds + (slot) * SHM_V + vst) = sr_[i].vs; *(LAS bf16x8*)(K_lds + (slot) * SHM_K + kst0) = sr_[i].ks0; \
    if (k2) *(LAS bf16x8*)(K_lds + (slot) * SHM_K + kst1) = sr_[i].ks1; } while (0)
#define RESC(a) do { if (!fixed) { if (__any((a) < 1.f)) { if (hi == 0) al_l[r32] = (a); asm volatile("s_waitcnt lgkmcnt(0)" ::: "memory"); \
    _Pragma("unroll") for (int d = 0; d < 2; ++d) _Pragma("unroll") for (int r = 0; r < 16; ++r) o[d][r] *= al_l[crow(r, hi)]; } } } while (0)
#define ROT() do { const int t_ = sp; sp = sc; sc = sn; sn = t_; } while (0)
    f32x16 pA0, pA1, pB0, pB1; float mnA, mnB, alA, alB; bf16x8 pa0, pa1, pa2, pa3;
    int sp = 0, sc = 1, sn = 2;
    SLOAD(0, 0); asm volatile("s_waitcnt vmcnt(0)" ::: "memory"); SWRITE(0, 0); SLOAD(1, 1); __syncthreads();
    qkt(pA0, pA1, K_lds, qr, r32, hi, negB); partialSM(pA0, pA1, m_reg, mnA, alA, fixed);
    SWRITE(1, 1); if (2 < NT) SLOAD(0, 2);
    __syncthreads();
    for (int j = 1; j + 1 < NT; j += 2) {
        SBAR(); qkt(pB0, pB1, K_lds + sc * SHM_K, qr, r32, hi, negB);
        finishSM(pA0, pA1, alA, l_reg, pa0, pa1, pa2, pa3); SBAR();
        SLOAD(1, j + 2); SBAR();
        pv_all(o, vb0 + sp * SHM_V, pa0, pa1, pa2, pa3); partialSM(pB0, pB1, m_reg, mnB, alB, fixed);
        SWRITE(sn, 0);
        RESC(alB); __syncthreads(); ROT();
        SBAR(); qkt(pA0, pA1, K_lds + sc * SHM_K, qr, r32, hi, negB);
        finishSM(pB0, pB1, alB, l_reg, pa0, pa1, pa2, pa3); SBAR();
        if (j + 3 < NT) SLOAD(0, j + 3); SBAR();
        pv_all(o, vb0 + sp * SHM_V, pa0, pa1, pa2, pa3); partialSM(pA0, pA1, m_reg, mnA, alA, fixed);
        SWRITE(sn, 1);
        RESC(alA); __syncthreads(); ROT();
    }
    SBAR(); qkt(pB0, pB1, K_lds + sc * SHM_K, qr, r32, hi, negB);
    finishSM(pA0, pA1, alA, l_reg, pa0, pa1, pa2, pa3); SBAR();
    pv_all(o, vb0 + sp * SHM_V, pa0, pa1, pa2, pa3); partialSM(pB0, pB1, m_reg, mnB, alB, fixed);
    RESC(alB);
    finishSM(pB0, pB1, alB, l_reg, pa0, pa1, pa2, pa3); SBAR();
    pv_all(o, vb0 + sc * SHM_V, pa0, pa1, pa2, pa3);
    if (hi == 0) li_l[r32] = l_reg; asm volatile("s_waitcnt lgkmcnt(0)" ::: "memory");
    bf16* Ow = O + (size_t)(qrow0 + wid * 32) * 1024 + h * 64 + r32;
#pragma unroll
    for (int r = 0; r < 16; ++r) { const int orow = crow(r, hi); const float rl = __builtin_amdgcn_rcpf(li_l[orow]);
#pragma unroll
        for (int d0 = 0; d0 < 2; ++d0) Ow[(size_t)orow * 1024 + d0 * 32] = (bf16)f2bf(o[d0][r] * rl); }
    __syncthreads();
#undef TROW
#undef SLOAD
#undef SWRITE
#undef RESC
#undef ROT
}
#undef KSWZ
#undef SBAR
}

enum { IX = 0, IC, ICTX, ICC, IADAW, IADAB, IMIXG, IFFNG, IWIN, IQLG, IKVLG, IWUQ, IWUKV, IQNG, IKNG, ICONVW, ICONVB, ICLNG, ICLNB, IWOUT, IFG, IFU, IFD, IRW, IMG, IMU, IMD, N_IN };
struct Args { const float* in[N_IN]; float* out; unsigned char* ws; int ph_lo, ph_hi; };
struct Frame {
    LAS unsigned char* lds; volatile LAS unsigned* MISC; gu32* ctl;
    int wave, G, gw, NGW;
    unsigned char* ws; float* out;
};
__device__ __forceinline__ const float* inp(int i) { asm volatile("" : "+s"(i)); return (const float*)((const GAS float* const*)__builtin_amdgcn_kernarg_segment_ptr())[i]; }
constexpr int CW_CNT = 8192;
constexpr int CW_SSQ = 16384;

__device__ __forceinline__ void transpose_tile(const float* __restrict__ W, int ldw, int k0, int n0, bf16* __restrict__ WT, int ldwt, int drow0, LAS float* scr, int lane, const float* kgain = nullptr) {
    const int n4 = (lane & 15) * 4, kq = lane >> 4;
    f32x4 v[16];
#pragma unroll
    for (int it = 0; it < 16; ++it) v[it] = *(const f32x4*)(W + (size_t)(k0 + 4 * it + kq) * ldw + n0 + n4);
#pragma unroll
    for (int it = 0; it < 16; ++it) { const int k = 4 * it + kq; if (kgain) v[it] = v[it] * kgain[k0 + k]; *(LAS f32x4*)(scr + k * 64 + (n4 ^ (((k >> 3) & 7) << 2))) = v[it]; }
    LDS_WAIT(); asm volatile("" ::: "memory");
    const int c = lane & 7;
#pragma unroll
    for (int it = 0; it < 8; ++it) { const int nn = (lane >> 3) + 8 * it; float s[8];
#pragma unroll
        for (int j = 0; j < 8; ++j) { const int k = 8 * c + j; s[j] = scr[k * 64 + (nn ^ (c << 2))]; }
        u32x4 o; o.x = pk2(s[0], s[1]); o.y = pk2(s[2], s[3]); o.z = pk2(s[4], s[5]); o.w = pk2(s[6], s[7]);
        *(u32x4*)(WT + (size_t)(drow0 + nn) * ldwt + k0 + 8 * c) = o; }
    LDS_WAIT(); asm volatile("" ::: "memory");
}
__device__ __forceinline__ int gu_row(int n, int up) { return (n >> 7) * 256 + up * 128 + (n & 127); }

constexpr int TT_IN = 16 * 19, TT_UQ = 6 * 12, TT_UKV = 4 * 16, TT_OUT = 16 * 16, TT_SMALL = 2 * (TT_IN + TT_UQ + TT_UKV + TT_OUT), TT_FF = 3 * 704, TT_ALL = TT_SMALL + 9 * TT_FF;
constexpr int FILL_P7 = 224 * 8 * 3;
__device__ __forceinline__ void transpose_item(unsigned char* ws, int it, LAS float* scr, int lane) {
    if (it < TT_SMALL) {
        const int l = it / (TT_SMALL / 2); int r = it % (TT_SMALL / 2);
        if (r < TT_IN) { const int nb = r % 19; int sc, dr;
            if (nb < 6) { sc = 64 * nb; dr = 64 * nb; } else if (nb == 6) { sc = 640; dr = C_KR; } else if (nb < 11) { sc = 384 + 64 * (nb - 7); dr = C_CKV + 64 * (nb - 7); }
            else if (nb < 13) { sc = 672 + 64 * (nb - 11); dr = 768 + 64 * (nb - 11); } else if (nb < 15) { sc = 928 + 64 * (nb - 13); dr = 896 + 64 * (nb - 13); }
            else if (nb < 17) { sc = 800 + 64 * (nb - 15); dr = 1024 + 64 * (nb - 15); } else { sc = 1056 + 64 * (nb - 17); dr = 1152 + 64 * (nb - 17); }
            transpose_tile(inp(IWIN) + (size_t)l * DM * INC, INC, (r / 19) * 64, sc, (bf16*)(ws + WS_WIN) + (size_t)l * NCOL * DM, DM, dr, scr, lane); return; } r -= TT_IN;
        if (r < TT_UQ) { transpose_tile(inp(IWUQ) + (size_t)l * QL * 768, 768, (r / 12) * 64, (r % 12) * 64, (bf16*)(ws + WS_WUQ) + (size_t)l * 768 * QL, QL, (r % 12) * 64, scr, lane, inp(IQLG) + l * QL); return; } r -= TT_UQ;
        if (r < TT_UKV) { transpose_tile(inp(IWUKV) + (size_t)l * KVL * 1024, 1024, (r / 16) * 64, (r % 16) * 64, (bf16*)(ws + WS_WUKV) + (size_t)l * 1024 * KVL, KVL, (r % 16) * 64, scr, lane, inp(IKVLG) + l * KVL); return; } r -= TT_UKV;
        transpose_tile(inp(IWOUT) + (size_t)l * DM * DM, DM, (r / 16) * 64, (r % 16) * 64, (bf16*)(ws + WS_WOUT) + (size_t)l * DM * DM, DM, (r % 16) * 64, scr, lane); return;
    }
    const int it2 = it - TT_SMALL, set = it2 / TT_FF, r = it2 % TT_FF, mat = r / 704, t = r % 704;
    const float* wg = set == 0 ? inp(IFG) : inp(IMG) + (size_t)(set - 1) * DM * DFF;
    const float* wu = set == 0 ? inp(IFU) : inp(IMU) + (size_t)(set - 1) * DM * DFF;
    const float* wd = set == 0 ? inp(IFD) : inp(IMD) + (size_t)(set - 1) * DFF * DM;
    bf16* dgu = set == 0 ? (bf16*)(ws + WS_WGU) : (bf16*)(ws + WS_MOEGU) + (size_t)(set - 1) * 2 * DFF * DM;
    bf16* dd = set == 0 ? (bf16*)(ws + WS_WD) : (bf16*)(ws + WS_MOED) + (size_t)(set - 1) * DM * DFF;
    if (mat < 2) { const int kb = t / 44, nb = t % 44; transpose_tile(mat == 0 ? wg : wu, DFF, kb * 64, nb * 64, dgu, DM, gu_row(nb * 64, mat), scr, lane); }
    else { const int kb = t / 16, nb = t % 16; transpose_tile(wd, DM, kb * 64, nb * 64, dd, DFF, nb * 64, scr, lane); }
}

__device__ __forceinline__ void prologue(const Args& a, Frame& F) {
    int lane_ = lane_id(), tid_ = F.wave * 64 + lane_; size_t z_ = 0; asm volatile("" : "+v"(lane_), "+v"(tid_), "+s"(z_)); unsigned char* ws_ = F.ws + z_;

    unsigned char* ws = ws_;
    LAS float* ldsf = (LAS float*)F.lds;
    for (int t = blockIdx.x; t < 192; t += F.G) {
        const int l = t / 96, cg = t % 96;
        for (int idx = tid_; idx < 9 * 1024; idx += 512) { const int bi = idx >> 10, k = idx & 1023; const float cv = bi < 8 ? inp(IC)[bi * 1024 + k] : inp(ICC)[k]; ldsf[idx] = cv / (1.0f + expf(-cv)); }
        __syncthreads();
        float acc[9];
#pragma unroll
        for (int bi = 0; bi < 9; ++bi) acc[bi] = 0.f;
        const float* wp = inp(IADAW) + ((size_t)l * 1024 + F.wave * 128) * 6144 + cg * 64 + lane_;
#pragma unroll 8
        for (int kk = 0; kk < 128; ++kk) { const float w = wp[(size_t)kk * 6144]; const int k = F.wave * 128 + kk;
#pragma unroll
            for (int bi = 0; bi < 9; ++bi) acc[bi] += ldsf[bi * 1024 + k] * w; }
        LAS float* red = ldsf + 9 * 1024;
#pragma unroll
        for (int bi = 0; bi < 9; ++bi) red[(F.wave * 9 + bi) * 64 + lane_] = acc[bi];
        __syncthreads();
        for (int idx = tid_; idx < 576; idx += 512) { const int bi = idx >> 6, c = idx & 63; float s = inp(IADAB)[l * 6144 + cg * 64 + c];
#pragma unroll
            for (int w = 0; w < 8; ++w) s += red[(w * 9 + bi) * 64 + c];
            ((float*)(ws + WS_MOD))[(size_t)(l * 9 + bi) * 6144 + cg * 64 + c] = s; }
        __syncthreads();
    }
    for (int t = blockIdx.x; t < 128; t += F.G) {
        const int l = t >> 6, g = (t >> 4) & 3, k0 = (t & 15) * 64;
        LAS float* Wl = ldsf; LAS float* tab = ldsf + 64 * 65;
        { const int k = tid_ >> 3, c8 = (tid_ & 7) * 8; const float* src = inp(IWIN) + ((size_t)l * DM + k0 + k) * INC + OFF_FOUR + g * 64 + c8;
          const f32x4 v0 = *(const f32x4*)src, v1 = *(const f32x4*)(src + 4);
#pragma unroll
          for (int e = 0; e < 4; ++e) { Wl[k * 65 + c8 + e] = v0[e]; Wl[k * 65 + c8 + 4 + e] = v1[e]; } }
        if (tid_ < 64) { tab[tid_] = cospif((float)tid_ / 32.0f); tab[64 + tid_] = sinpif((float)tid_ / 32.0f); }
        __syncthreads();
        const int k = tid_ & 63;
        for (int i = 0; i < 16; ++i) { const int pc = (tid_ >> 6) + 8 * i, part = pc >> 6, cp = pc & 63; float s = 0.f;
#pragma unroll 8
            for (int c = 0; c < 64; ++c) s += Wl[k * 65 + c] * tab[part * 64 + ((c * cp) & 63)];
            ((bf16*)(ws + WS_WFT))[((size_t)l * 512 + part * 256 + g * 64 + cp) * DM + k0 + k] = (bf16)f2bf(0.125f * s); }
        __syncthreads();
    }
    {
        LAS float* ctab = ldsf;
        for (int m = tid_; m < 2048; m += 512) ctab[m] = cospif((float)m / 1024.0f);
        __syncthreads();
        const float sc = 0.02209708691207961f;
        for (int k = blockIdx.x; k < 256; k += F.G) {
            if (tid_ < 64) { const int kk0 = tid_ * 8; unsigned w[4];
#pragma unroll
                for (int e = 0; e < 8; e += 2) { float v[2];
#pragma unroll
                    for (int q = 0; q < 2; ++q) { const int kk = kk0 + e + q; const int s = kk & 255; const int m = ((k * s) & 255) * 8; v[q] = kk < 256 ? ctab[m] * 0.0625f : -ctab[(m - 512) & 2047] * 0.0625f; }
                    w[e >> 1] = pk2(v[0], v[1]); }
                *(u32x4*)((bf16*)(ws + WS_DFTC) + (size_t)k * 512 + kk0) = (u32x4){w[0], w[1], w[2], w[3]}; }
        }
        __syncthreads();
    }
    for (int e = blockIdx.x * 512 + tid_; e < 2048 * 16; e += F.G * 512) { const int t = e >> 4, i = e & 15; const float pos = (float)(i < 8 ? (t >> 6) : (t & 63));
        const float inv = powf(10000.0f, -(float)(i & 7) * 0.125f); const float ang = pos * inv;
        ((float*)(ws + WS_ROPE))[t * 32 + i] = cosf(ang); ((float*)(ws + WS_ROPE))[t * 32 + 16 + i] = sinf(ang); }
    for (int e = blockIdx.x * 512 + tid_; e < 2 * 64 * DM / 8; e += F.G * 512) { const int l = e / (64 * DM / 8), r = e % (64 * DM / 8);
        *(u32x4*)((bf16*)(ws + WS_WIN) + ((size_t)l * NCOL + 448) * DM + (size_t)r * 8) = (u32x4){0u, 0u, 0u, 0u}; }
    { LAS float* scr = ldsf + F.wave * 4096;
      for (int it = F.gw; it < TT_ALL - FILL_P7; it += F.NGW) transpose_item(ws, it, scr, lane_); }
}

__device__ __forceinline__ const float* modp(const unsigned char* ws, int l, int bi, int which) { return (const float*)(ws + WS_MOD) + (size_t)(l * 9 + bi) * 6144 + which * 1024; }

template <bool ROUTER>
__device__ __forceinline__ void adaln_pass(const Frame& F, int l, int wsh, const float* gain, const float* srcx, const float* srcc, bool do_ctx, const float* router_w) {
    int lane_ = lane_id(), tid_ = F.wave * 64 + lane_; size_t z_ = 0; asm volatile("" : "+v"(lane_), "+v"(tid_), "+s"(z_)); unsigned char* ws_ = F.ws + z_;

    bf16* h = (bf16*)(ws_ + DY_H);
    LAS float* rwl = (LAS float*)F.lds;
    if (ROUTER) { for (int idx = tid_; idx < 8192; idx += 512) { const int k = idx >> 3, e = idx & 7; rwl[e * 1024 + k] = router_w[idx]; } __syncthreads(); }
    for (int gwi = F.gw; gwi < 2048; gwi += F.NGW) {
        for (int pass = 0; pass < (do_ctx ? 2 : 1); ++pass) {
            const int bi = pass == 0 ? (gwi >> 8) : 8;
            const float* sh = modp(ws_, l, bi, wsh); const float* sc = modp(ws_, l, bi, wsh + 1);
            f32x4 A[4], Bv[4];
#pragma unroll
            for (int j = 0; j < 4; ++j) { const int col = 256 * j + 4 * lane_; const f32x4 g4 = *(const f32x4*)(gain + col), s4 = *(const f32x4*)(sc + col); A[j] = g4 * (1.0f + s4); Bv[j] = *(const f32x4*)(sh + col); }
            const int nrow = pass == 0 ? 8 : 1;
            for (int rr = 0; rr < nrow; ++rr) {
                const int r = pass == 0 ? gwi * 8 + rr : gwi;
                const float* src = (pass == 0 ? srcx : srcc) + (size_t)r * DM;
                bf16* dst = h + (size_t)(pass == 0 ? r : RX + r) * DM;
                f32x4 v[4]; float ss = 0.f;
#pragma unroll
                for (int j = 0; j < 4; ++j) { v[j] = *(const f32x4*)(src + 256 * j + 4 * lane_); ss += (v[j].x * v[j].x + v[j].y * v[j].y) + (v[j].z * v[j].z + v[j].w * v[j].w); }
                const float rinv = 1.0f / sqrtf(wave_sum(ss) * (1.0f / DM) + EPS);
#pragma unroll
                for (int j = 0; j < 4; ++j) { v[j] = v[j] * rinv * A[j] + Bv[j];
                    u32x2 o; o.x = pk2(v[j].x, v[j].y); o.y = pk2(v[j].z, v[j].w); *(u32x2*)(dst + 256 * j + 4 * lane_) = o; }
                if (ROUTER) {
                    float lg[8];
#pragma unroll
                    for (int e = 0; e < 8; ++e) { float s = 0.f;
#pragma unroll
                        for (int j = 0; j < 4; ++j) { const f32x4 w4 = *(const LAS f32x4*)(rwl + e * 1024 + 256 * j + 4 * lane_); s += (v[j].x * w4.x + v[j].y * w4.y) + (v[j].z * w4.z + v[j].w * w4.w); }
                        lg[e] = wave_sum(s); }
                    int e0 = 0; float l0 = lg[0];
#pragma unroll
                    for (int e = 1; e < 8; ++e) if (lg[e] > l0) { l0 = lg[e]; e0 = e; }
                    int e1 = -1; float l1 = -3.0e38f;
#pragma unroll
                    for (int e = 0; e < 8; ++e) if (e != e0 && lg[e] > l1) { l1 = lg[e]; e1 = e; }
                    const float w0 = 1.0f / (1.0f + expf(l1 - l0));
                    if (lane_ == 0) { ((int*)(ws_ + WS_MOE + MO_TOKE))[r] = e0 | (e1 << 8); ((float*)(ws_ + WS_MOE + MO_TOKW))[2 * r] = w0; ((float*)(ws_ + WS_MOE + MO_TOKW))[2 * r + 1] = 1.0f - w0;
                        atomicAdd((int*)F.ctl + CW_CNT + (r >> 6) * 16 + e0, 1); atomicAdd((int*)F.ctl + CW_CNT + (r >> 6) * 16 + 8 + e1, 1); }
                }
            }
        }
    }
}

__device__ __forceinline__ void conv_pass(const Frame& F, const float* cw, const float* cb, const float* lg, const float* lb, const int wg0) {
    int lane_ = lane_id(), tid_ = F.wave * 64 + lane_; size_t z_ = 0; asm volatile("" : "+v"(lane_), "+v"(tid_), "+s"(z_)); unsigned char* ws_ = F.ws + z_;

    const bf16* y = (const bf16*)(ws_ + DY_Y); bf16* mix = (bf16*)(ws_ + DY_M);
    const int ch = 4 * lane_;
    LAS float* wl = (LAS float*)F.lds;
    __syncthreads();
    for (int idx = tid_; idx < 45 * CCH; idx += 512) { const int jj = idx >> 8; wl[idx] = (jj >= 7 && jj < 7 + CWID) ? cw[idx - 7 * CCH] : 0.f; }
    __syncthreads();
    const f32x4 bv = *(const f32x4*)(cb + ch), gv = *(const f32x4*)(lg + ch), bb = *(const f32x4*)(lb + ch);
    for (int ct = F.gw - wg0 * 8; ct < RT / 8; ct += F.NGW - wg0 * 8) {
        const int r0 = ct * 8;
        const int s0 = r0 < RX ? (r0 & ~(SEQ - 1)) : RX + ((r0 - RX) & ~(CTXL - 1)), s1 = s0 + (r0 < RX ? SEQ : CTXL);
        u32x2 yr[8 + CWID - 1];
#pragma unroll
        for (int i = 0; i < 8 + CWID - 1; ++i) { const int rr = r0 - 15 + i; yr[i] = (u32x2){0u, 0u}; if (rr >= s0 && rr < s1) yr[i] = *(const u32x2*)(y + (size_t)rr * CCH + ch); }
        f32x4 acc[8];
#pragma unroll
        for (int o = 0; o < 8; ++o) acc[o] = bv;
#pragma unroll
        for (int i = 0; i < 8 + CWID - 1; ++i) { const f32x4 yv = (f32x4){bflo(yr[i].x), bfhi(yr[i].x), bflo(yr[i].y), bfhi(yr[i].y)};
#pragma unroll
            for (int o = 0; o < 8; ++o) { const int j = i - o; if (j >= 0 && j < CWID) acc[o] += yv * *(const LAS f32x4*)(wl + (j + 7) * CCH + ch); } }
#pragma unroll
        for (int o = 0; o < 8; ++o) { const f32x4 v = acc[o];
            const float mean = wave_sum((v.x + v.y) + (v.z + v.w)) * (1.0f / CCH); const f32x4 d = v - mean;
            const float var = wave_sum((d.x * d.x + d.y * d.y) + (d.z * d.z + d.w * d.w)) * (1.0f / CCH); const float rs = 1.0f / sqrtf(var + EPS);
            const f32x4 n = d * rs * gv + bb;
            u32x2 w; w.x = pk2(siluf_(n.x), siluf_(n.y)); w.y = pk2(siluf_(n.z), siluf_(n.w));
            *(u32x2*)(mix + (size_t)(r0 + o) * DM + 512 + ch) = w; }
    }
}

__device__ __forceinline__ void fft_stage_a(const Frame& F) {
    int lane_ = lane_id(), tid_ = F.wave * 64 + lane_; size_t z_ = 0; asm volatile("" : "+v"(lane_), "+v"(tid_), "+s"(z_)); unsigned char* ws_ = F.ws + z_;
    LAS float* ctab = (LAS float*)F.lds;
    __syncthreads();
    for (int m = tid_; m < 2048; m += 512) ctab[m] = cospif((float)m / 1024.0f);
    __syncthreads();
    const float R = 0.70710678118654752f, IS8 = 0.35355339059327376f;
    const float c8[8] = {1.f, R, 0.f, -R, -1.f, -R, 0.f, R}, s8[8] = {0.f, R, 1.f, R, 0.f, -R, -1.f, -R};
    for (int row = F.gw; row < NB * 256; row += F.NGW) {
        bf16* zr = (bf16*)(ws_ + DY_Z) + (size_t)row * 4096 + 4 * lane_;
        float yr[8][4], yi[8][4];
#pragma unroll
        for (int s1 = 0; s1 < 8; ++s1) { const u32x2 a = *(const u32x2*)(zr + 256 * s1), b = *(const u32x2*)(zr + 2048 + 256 * s1);
            yr[s1][0] = bflo(a.x); yr[s1][1] = bfhi(a.x); yr[s1][2] = bflo(a.y); yr[s1][3] = bfhi(a.y);
            yi[s1][0] = -bflo(b.x); yi[s1][1] = -bfhi(b.x); yi[s1][2] = -bflo(b.y); yi[s1][3] = -bfhi(b.y); }
#pragma unroll
        for (int k1 = 0; k1 < 8; ++k1) { float pr[4], pi[4];
#pragma unroll
            for (int e = 0; e < 4; ++e) { float ar = 0.f, ai = 0.f;
#pragma unroll
                for (int s1 = 0; s1 < 8; ++s1) { const float c = c8[(k1 * s1) & 7], sn = s8[(k1 * s1) & 7]; ar += yr[s1][e] * c + yi[s1][e] * sn; ai += yi[s1][e] * c - yr[s1][e] * sn; }
                const int m = (k1 * (4 * lane_ + e)) & 2047; const float cb = ctab[m], sb = ctab[(m - 512) & 2047];
                pr[e] = (ar * cb + ai * sb) * IS8; pi[e] = -(ai * cb - ar * sb) * IS8; }
            u32x2 o0, o1; o0.x = pk2(pr[0], pr[1]); o0.y = pk2(pr[2], pr[3]); o1.x = pk2(pi[0], pi[1]); o1.y = pk2(pi[2], pi[3]);
            *(u32x2*)(zr + k1 * 512) = o0; *(u32x2*)(zr + k1 * 512 + 256) = o1; }
    }
}

__device__ __forceinline__ void t5_pass(const Frame& F, const float* qg, const float* kg) {
    int lane_ = lane_id(), tid_ = F.wave * 64 + lane_; size_t z_ = 0; asm volatile("" : "+v"(lane_), "+v"(tid_), "+s"(z_)); unsigned char* ws_ = F.ws + z_;

    bf16* q = (bf16*)(ws_ + DY_Q); const bf16* kvp = (const bf16*)(ws_ + DY_KV); const bf16* cols = (const bf16*)(ws_ + DY_C); bf16* kk = (bf16*)(ws_ + DY_K);
    const float* rope = (const float*)(ws_ + WS_ROPE);
    const int hh = lane_ >> 3, sub = lane_ & 7; const float QS = 0.10206207261596577f * 1.4426950408889634f;
    float gqn[8], gkn[8], gqr[4], gkr[4];
#pragma unroll
    for (int e = 0; e < 8; ++e) { gqn[e] = qg[8 * sub + e]; gkn[e] = kg[8 * sub + e]; }
#pragma unroll
    for (int e = 0; e < 2; ++e) { gqr[e] = qg[64 + 2 * sub + e]; gqr[2 + e] = qg[80 + 2 * sub + e]; gkr[e] = kg[64 + 2 * sub + e]; gkr[2 + e] = kg[80 + 2 * sub + e]; }
    for (int r = F.gw; r < RT; r += F.NGW) {
        float cs[2] = {1.f, 1.f}, sn[2] = {0.f, 0.f};
        if (r < RX) { const int t = r & (SEQ - 1); cs[0] = rope[t * 32 + 2 * sub]; cs[1] = rope[t * 32 + 2 * sub + 1]; sn[0] = rope[t * 32 + 16 + 2 * sub]; sn[1] = rope[t * 32 + 16 + 2 * sub + 1]; }
#pragma unroll
        for (int isk = 1; isk < 2; ++isk) {
            const bf16* pn = isk ? kvp + (size_t)r * 1024 + hh * 128 + 8 * sub : q + (size_t)r * 768 + hh * 96 + 8 * sub;
            const bf16* p1 = isk ? cols + (size_t)r * NC3 + C_KR + 2 * sub : q + (size_t)r * 768 + hh * 96 + 64 + 2 * sub;
            const u32x4 wn = *(const u32x4*)pn; const unsigned w1 = *(const unsigned*)p1, w2 = *(const unsigned*)(p1 + 16);
            float v[8] = {bflo(wn.x), bfhi(wn.x), bflo(wn.y), bfhi(wn.y), bflo(wn.z), bfhi(wn.z), bflo(wn.w), bfhi(wn.w)};
            float x1[2] = {bflo(w1), bfhi(w1)}, x2[2] = {bflo(w2), bfhi(w2)};
            float ss = x1[0] * x1[0] + x1[1] * x1[1] + x2[0] * x2[0] + x2[1] * x2[1];
#pragma unroll
            for (int e = 0; e < 8; ++e) ss += v[e] * v[e];
            ss = sum8(ss);
            const float rinv = (1.0f / sqrtf(ss * (1.0f / QKH) + EPS)) * (isk ? 1.0f : QS);
            const float* gn = isk ? gkn : gqn; const float* gr = isk ? gkr : gqr;
#pragma unroll
            for (int e = 0; e < 8; ++e) v[e] *= rinv * gn[e];
#pragma unroll
            for (int e = 0; e < 2; ++e) { x1[e] *= rinv * gr[e]; x2[e] *= rinv * gr[2 + e]; }
            const float o1a = x1[0] * cs[0] - x2[0] * sn[0], o1b = x1[1] * cs[1] - x2[1] * sn[1], o2a = x2[0] * cs[0] + x1[0] * sn[0], o2b = x2[1] * cs[1] + x1[1] * sn[1];
            bf16* dn = (isk ? kk : q) + (size_t)r * 768 + hh * 96;
            u32x4 o; o.x = pk2(v[0], v[1]); o.y = pk2(v[2], v[3]); o.z = pk2(v[4], v[5]); o.w = pk2(v[6], v[7]);
            *(u32x4*)(dn + 8 * sub) = o; *(unsigned*)(dn + 64 + 2 * sub) = pk2(o1a, o1b); *(unsigned*)(dn + 80 + 2 * sub) = pk2(o2a, o2b);
        }
    }
}

__device__ __forceinline__ void moe_assign(const Frame& F, int k) {
    int lane_ = lane_id(), tid_ = F.wave * 64 + lane_; size_t z_ = 0; asm volatile("" : "+v"(lane_), "+v"(tid_), "+s"(z_)); unsigned char* ws_ = F.ws + z_;
    LAS int* li = (LAS int*)F.lds;
    const int* cnt = (const int*)F.ctl + CW_CNT;
    const int* toke = (const int*)(ws_ + WS_MOE + MO_TOKE); const float* tokw = (const float*)(ws_ + WS_MOE + MO_TOKW);
    int* srow = (int*)(ws_ + WS_MOE + MO_SROW) + k * 32768; float* sw = (float*)(ws_ + WS_MOE + MO_SW) + k * 32768; int* meta = (int*)(ws_ + WS_MOE + MO_META) + 16 * k;
    const bf16* h = (const bf16*)(ws_ + DY_H); bf16* hg = (bf16*)(ws_ + DY_M);
    for (int rg = blockIdx.x; rg < 256; rg += F.G) {
        { const int e = F.wave; int tot = 0, bef = 0;
#pragma unroll
            for (int q = 0; q < 4; ++q) { const int g = 4 * lane_ + q; const int c = __hip_atomic_load(cnt + g * 16 + 8 * k + e, RLX_AGENT); tot += c; bef += g < rg ? c : 0; }
            tot = wave_isum(tot); bef = wave_isum(bef);
            if (lane_ == 0) { li[2048 + e] = tot; li[2056 + e] = bef; } }
        __syncthreads();
        if (tid_ == 0) { int pb = 0; for (int e = 0; e < 8; ++e) { li[2064 + e] = pb * 256; if (rg == 0) meta[e] = pb; pb += (li[2048 + e] + 255) >> 8; } li[2072] = pb * 256; if (rg == 0) meta[8] = pb; }
        __syncthreads();
        if (F.wave == 0) { const int r = rg * 64 + lane_; const int ek = (toke[r] >> (8 * k)) & 0xff; int rank = 0;
#pragma unroll
            for (int e = 0; e < 8; ++e) { const unsigned long long m = __ballot(ek == e); if (ek == e) rank = __popcll(m & ((1ull << lane_) - 1ull)); }
            const int slot = li[2064 + ek] + li[2056 + ek] + rank; srow[slot] = r; sw[slot] = tokw[2 * r + k]; li[2080 + lane_] = slot; }
        if (rg == 0) { for (int e = 0; e < 8; ++e) { const int b0 = li[2064 + e] + li[2048 + e], b1 = li[2064 + e + 1]; for (int s2 = b0 + tid_; s2 < b1; s2 += 512) { srow[s2] = -1; sw[s2] = 0.f; } } }
        __syncthreads();
        for (int i = F.wave * 8; i < F.wave * 8 + 8; ++i) { const int slot = li[2080 + i]; const u32x4* src = (const u32x4*)(h + (size_t)(rg * 64 + i) * DM); u32x4* dst = (u32x4*)(hg + (size_t)slot * DM);
            dst[lane_] = src[lane_]; dst[64 + lane_] = src[64 + lane_]; }
        __syncthreads();
    }
}

using pg8::Unit;
struct SchedIn {
    int G, c, l; unsigned char* ws;
    __device__ __forceinline__ bool next(int i, Unit& u) const { int L = i * G + c; if (L < 360) { u.pm = L / 5; u.pn = L % 5; return true; } L -= 360; if (L >= 144) return false; u.pm = 72 + L / 72; u.pn = L % 72; return true; }
    __device__ __forceinline__ const char* aptr(const Unit& u) const { return u.pm < 72 ? (const char*)(ws + DY_H) + (size_t)u.pm * 256 * DM * 2 : (const char*)(ws + WS_WFT) + ((size_t)l * 512 + (u.pm - 72) * 256) * DM * 2; }
    __device__ __forceinline__ const char* bptr(const Unit& u) const { return u.pm < 72 ? (const char*)(ws + WS_WIN) + ((size_t)l * NCOL + u.pn * 256) * DM * 2 : (const char*)(ws + DY_H) + (size_t)u.pn * 256 * DM * 2; }
};
struct EpiIn {
    static constexpr bool PERM = true; unsigned char* ws; float* ssq;
    __device__ __forceinline__ void operator()(const f32x4 (&acc)[2][2][4][2], const Unit& u, int wr, int wc, int fr, int fq) const {
        if (u.pm < 72) {
            bf16* C = (bf16*)(ws + DY_C) + (size_t)u.pm * 256 * NC3 + u.pn * 256;
            if (u.pn == 0) pg8::store_tile_bf16_ssq<2>(acc, C, NC3, ssq + (size_t)u.pm * 256 * 12 + wc, wr, wc, fr, fq);
            else if (u.pn == 1) pg8::store_tile_bf16_ssq<1>(acc, C, NC3, ssq + (size_t)u.pm * 256 * 12 + 4 + wc, wr, wc, fr, fq);
            else if (u.pn == 2) pg8::store_tile_bf16_ssq<2>(acc, C, NC3, ssq + (size_t)u.pm * 256 * 12 + 8 + wc, wr, wc, fr, fq);
            else pg8::store_tile_glu(acc, (bf16*)(ws + DY_Y) + (size_t)u.pm * 256 * CCH + (u.pn - 3) * 128, CCH, wr, wc, fr, fq);
        }
        else if (u.pn < 64) pg8::store_tile_bf16(acc, (bf16*)(ws + DY_Z) + ((size_t)(u.pn >> 3) * 256) * 4096 + (u.pm - 72) * 2048 + (u.pn & 7) * 256, 4096, wr, wc, fr, fq);
        else pg8::store_tile_bf16(acc, (bf16*)(ws + DY_Z + 16 * MiB) + (size_t)(u.pn - 64) * 256 * 512 + (u.pm - 72) * 256, 512, wr, wc, fr, fq);
    }
};
template <int LDC, int KDIM>
struct EpiUp {
    static constexpr bool PERM = true; bf16* C; const float* ssq;
    __device__ __forceinline__ void operator()(const f32x4 (&acc)[2][2][4][2], const Unit& u, int wr, int wc, int fr, int fq) const {
        pg8::store_tile_bf16_rs<KDIM == QL ? 8 : 4>(acc, C + (size_t)u.pm * 256 * LDC + u.pn * 256, LDC, ssq + (size_t)u.pm * 256 * 12, 1.0f / KDIM, wr, wc, fr, fq);
    }
};
template <int NPAN, int NTN, int LDA, int LDB, int ROT = 0>
struct SchedPlain {
    int G, c; const char* A; const char* B;
    __device__ __forceinline__ bool next(int i, Unit& u) const { const int cc = ROT ? (c + ROT) % G : c; const int L = i * G + cc; if (L >= NPAN * NTN) return false; u.pm = L / NTN; u.pn = L % NTN; return true; }
    __device__ __forceinline__ const char* aptr(const Unit& u) const { return A + (size_t)u.pm * 256 * LDA * 2; }
    __device__ __forceinline__ const char* bptr(const Unit& u) const { return B + (size_t)u.pn * 256 * LDB * 2; }
};
template <int LDC, bool SWIGLU>
struct EpiPlain {
    static constexpr bool PERM = true; bf16* C;
    __device__ __forceinline__ void operator()(const f32x4 (&acc)[2][2][4][2], const Unit& u, int wr, int wc, int fr, int fq) const {
        if (SWIGLU) pg8::store_tile_swiglu(acc, C + (size_t)u.pm * 256 * LDC + u.pn * 128, LDC, wr, wc, fr, fq);
        else pg8::store_tile_bf16(acc, C + (size_t)u.pm * 256 * LDC + u.pn * 256, LDC, wr, wc, fr, fq);
    }
};
struct SchedGUa {
    int G, c; const char* A; const char* B;
    __device__ __forceinline__ bool next(int i, Unit& u) const { const int L = i * G + c; if (L >= 256) return false; if (L < 176) { u.pm = 64 + L / 22; u.pn = L % 22; } else { const int j = L - 176; u.pm = j / 22; u.pn = j % 22; } return true; }
    __device__ __forceinline__ const char* aptr(const Unit& u) const { return A + (size_t)u.pm * 256 * DM * 2; }
    __device__ __forceinline__ const char* bptr(const Unit& u) const { return B + (size_t)u.pn * 256 * DM * 2; }
};
struct SchedGUb {
    int G, c; const char* A; const char* B;
    __device__ __forceinline__ bool next(int i, Unit& u) const {
        int j;
        if (G == 256) { if (c < 32) { if (i >= 3) return false; j = 80 + c * 3 + i; } else { j = 176 + (c - 32) + 224 * i; } }
        else j = 80 + i * G + c;
        if (j >= 64 * 22) return false; u.pm = j / 22; u.pn = j % 22; return true; }
    __device__ __forceinline__ const char* aptr(const Unit& u) const { return A + (size_t)u.pm * 256 * DM * 2; }
    __device__ __forceinline__ const char* bptr(const Unit& u) const { return B + (size_t)u.pn * 256 * DM * 2; }
};
template <int NPM, int K>
struct SchedDft {
    int G, c; const char* dft; const char* zt;
    __device__ __forceinline__ bool next(int i, Unit& u) const { const int L = i * G + c; if (L >= NB * NPM) return false; u.pm = L / NPM; u.pn = L % NPM; return true; }
    __device__ __forceinline__ const char* aptr(const Unit& u) const { return dft + (size_t)u.pn * 256 * K * 2; }
    __device__ __forceinline__ const char* bptr(const Unit& u) const { return zt + (size_t)u.pm * 256 * K * 2; }
};
template <int ROWS_PER_B>
struct EpiDft {
    static constexpr bool PERM = true; bf16* mix0;
    __device__ __forceinline__ void operator()(const f32x4 (&acc)[2][2][4][2], const Unit& u, int wr, int wc, int fr, int fq) const {
        pg8::store_tile_bf16(acc, mix0 + (size_t)(u.pm * ROWS_PER_B + u.pn * 256) * DM, DM, wr, wc, fr, fq);
    }
};
struct SchedFftC {
    int G, c; const char* dft; const char* zt;
    __device__ __forceinline__ bool next(int i, Unit& u) const { const int L = i * G + c; if (L >= NB * 8) return false; u.pm = L >> 3; u.pn = L & 7; return true; }
    __device__ __forceinline__ const char* aptr(const Unit&) const { return dft; }
    __device__ __forceinline__ const char* bptr(const Unit& u) const { return zt + ((size_t)u.pm * 256 * 4096 + u.pn * 512) * 2; }
};
struct EpiFftC {
    static constexpr bool PERM = true; bf16* mix0;
    __device__ __forceinline__ void operator()(const f32x4 (&acc)[2][2][4][2], const Unit& u, int wr, int wc, int fr, int fq) const {
        pg8::store_tile_bf16(acc, mix0 + (size_t)(u.pm * SEQ + u.pn) * DM, 8 * DM, wr, wc, fr, fq);
    }
};
template <int LDA>
struct SchedResid {
    int G, c, pm0, npan; const char* A; const char* B;
    __device__ __forceinline__ bool next(int i, Unit& u) const { const int L = i * G + c; if (L >= npan * 4) return false; u.pm = pm0 + (L >> 2); u.pn = L & 3; return true; }
    __device__ __forceinline__ const char* aptr(const Unit& u) const { return A + (size_t)u.pm * 256 * LDA * 2; }
    __device__ __forceinline__ const char* bptr(const Unit& u) const { return B + (size_t)u.pn * 256 * LDA * 2; }
};
struct EpiResid {
    static constexpr bool PERM = false;
    const float* xin; const float* cin; float* xout; float* cout; const float* gate;
    __device__ __forceinline__ void operator()(const f32x4 (&acc)[2][2][4][2], const Unit& u, int wr, int wc, int fr, int fq) const {
        if (u.pm < 64) { const size_t off = (size_t)u.pm * 256 * DM + u.pn * 256; pg8::store_tile_resid(acc, xin + off, xout + off, gate + (size_t)(u.pm >> 3) * 6144 + u.pn * 256, wr, wc, fr, fq); }
        else { const size_t off = (size_t)(u.pm - 64) * 256 * DM + u.pn * 256; pg8::store_tile_resid(acc, cin + off, cout + off, gate + (size_t)8 * 6144 + u.pn * 256, wr, wc, fr, fq); }
    }
};
template <int MODE>
struct SchedMoe {
    static constexpr bool DOWN = MODE >= 2;
    int G, c; const int* meta; unsigned char* ws;
    __device__ __forceinline__ bool next(int i, Unit& u) const {
        const int NP = __builtin_amdgcn_readfirstlane(meta[8]); int ned = 4 * NP - G; ned = ned < 0 ? 0 : ned; { const int cap = (G / 22) * 4; ned = ned > cap ? cap : ned; } ned &= ~3;
        if (MODE == 0) { const int L = i * G + c; if (i > 0 || L >= NP * 22) return false; u.pm = L / 22; u.pn = L % 22; return true; }
        if (MODE == 1) { int j; if (c < ned) { if (i >= 3) return false; j = G + c * 3 + i; } else { j = G + 3 * ned + (c - ned) + (G - ned) * i; } if (j >= NP * 22) return false; u.pm = j / 22; u.pn = j % 22; return true; }
        if (MODE == 2) { const int L = i * G + c; if (L >= ned) return false; u.pm = L >> 2; u.pn = L & 3; return true; }
        { const int L = i * G + c; const int ne = ned >> 2; if (L >= (NP - ne) * 4) return false; u.pm = ne + (L >> 2); u.pn = L & 3; return true; }
    }
    __device__ __forceinline__ int expert(int sp) const { int e = 0;
#pragma unroll
        for (int j = 1; j < 8; ++j) e += sp >= __builtin_amdgcn_readfirstlane(meta[j]) ? 1 : 0;
        return e; }
    __device__ __forceinline__ const char* aptr(const Unit& u) const { return DOWN ? (const char*)(ws + DY_ACT) + (size_t)u.pm * 256 * DFF * 2 : (const char*)(ws + DY_M) + (size_t)u.pm * 256 * DM * 2; }
    __device__ __forceinline__ const char* bptr(const Unit& u) const { const int e = expert(u.pm);
        return DOWN ? (const char*)(ws + WS_MOED) + ((size_t)e * DM + u.pn * 256) * DFF * 2 : (const char*)(ws + WS_MOEGU) + ((size_t)e * 2 * DFF + u.pn * 256) * DM * 2; }
};
struct EpiMoeDown {
    static constexpr bool PERM = false;
    const int* srow; const float* sw; const float* gate; float* out;
    __device__ __forceinline__ void operator()(const f32x4 (&acc)[2][2][4][2], const Unit& u, int wr, int wc, int fr, int fq) const {
        const int col0 = u.pn * 256 + wc * 32 + 4 * fq;
#pragma unroll
        for (int ai = 0; ai < 2; ++ai)
#pragma unroll
            for (int m = 0; m < 4; ++m) { const int slot = u.pm * 256 + ai * 128 + wr * 64 + m * 16 + fr; const int tok = srow[slot];
                if (tok >= 0) { const float w = sw[slot]; const float* g = gate + (size_t)(tok >> 11) * 6144 + col0; float* orow = out + (size_t)tok * DM + col0;
#pragma unroll
                    for (int bj = 0; bj < 2; ++bj)
#pragma unroll
                        for (int n = 0; n < 2; ++n) { const f32x4 gv = *(const f32x4*)(g + bj * 128 + n * 16); const f32x4 xv = *(const f32x4*)(orow + bj * 128 + n * 16);
                            *(f32x4*)(orow + bj * 128 + n * 16) = xv + gv * w * acc[ai][bj][m][n]; } } }
    }
};

#ifndef EN_MASK
#define EN_MASK 0xFFFFFFFFu
#endif
#ifndef PROBE_SITE
#define PROBE_SITE -1
#endif
#define RPT(n) for (int rep_ = 0; rep_ < ((PROBE_SITE) == (n) ? 2 : 1); ++rep_)
#define EN(n) (((EN_MASK) >> (n)) & 1u)
#define IN(k) (lo <= (k) && (k) < hi)
#define SEAM(k) do { if (!MK_PER_PHASE && IN(k) && IN((k) + 1)) xcd_barrier(bar); } while (0)
#define SITE if (PROBE_SITE >= 0 && rep_ > 0) xcd_barrier(bar); size_t z_ = 0; int cid = blockIdx.x, G = gridDim.x; if ((G & 7) == 0) cid = (cid & 7) * (G >> 3) + (cid >> 3); asm volatile("" : "+s"(z_), "+s"(cid), "+s"(G)); unsigned char* ws = a.ws + z_;

template <int L>
__device__ __forceinline__ void mixer_phases(const Args& a, Frame& F, const XcdBarrier& bar, const int lo, const int hi) {
    constexpr int rep_ = 0; (void)rep_;
    constexpr int P = L == 0 ? 1 : 11;
    LAS unsigned char* ring = F.lds;
    RPT(1) if (EN(1) && IN(P + 0)) { SITE adaln_pass<false>(F, L, 0, inp(IMIXG) + L * DM, L == 0 ? inp(IX) : ((float*)(GAS float*)a.out), L == 0 ? inp(ICTX) : (const float*)(ws + WS_CTXS), true, nullptr); } SEAM(P + 0);
    RPT(2) if (EN(2) && IN(P + 1)) { SITE
        SchedIn S{G, cid, L, ws};
        pg8::gemm_phase(ring, F.wave, pg8::GemmK{DM, DM, DM}, S, EpiIn{ws, (float*)(ws + WS_SSQP) + (size_t)L * RT * 12});
    } SEAM(P + 1);
    RPT(4) if (EN(4) && IN(P + 2)) { SITE
        SchedPlain<72, 3, NC3, QL> S{G, cid, (const char*)(ws + DY_C), (const char*)(ws + WS_WUQ) + (size_t)L * 768 * QL * 2};
        pg8::gemm_phase(ring, F.wave, pg8::GemmK{NC3, QL, QL}, S, EpiUp<768, QL>{(bf16*)(ws + DY_Q), (const float*)(ws + WS_SSQP) + (size_t)L * RT * 12}); }
    RPT(17) if (EN(17) && IN(P + 2)) { SITE
        SchedPlain<72, 4, NC3, KVL, 40> S{G, cid, (const char*)(ws + DY_C) + C_CKV * 2, (const char*)(ws + WS_WUKV) + (size_t)L * 1024 * KVL * 2};
        pg8::gemm_phase(ring, F.wave, pg8::GemmK{NC3, KVL, KVL}, S, EpiUp<1024, KVL>{(bf16*)(ws + DY_KV), (const float*)(ws + WS_SSQP) + (size_t)L * RT * 12 + 8}); }
    if (L == 0) { RPT(16) if (EN(16) && IN(P + 2)) { SITE
        SchedDft<1, 512> S{G, (cid + 8) % G, (const char*)(ws + WS_DFTC), (const char*)(ws + DY_Z + 16 * MiB)};
        pg8::gemm_phase(ring, F.wave, pg8::GemmK{512, 512, 512}, S, EpiDft<CTXL>{(bf16*)(ws + DY_M) + (size_t)RX * DM + 768}); } }
    RPT(18) if (EN(18) && IN(P + 2)) { SITE conv_pass(F, inp(ICONVW) + L * CWID * CCH, inp(ICONVB) + L * CCH, inp(ICLNG) + L * CCH, inp(ICLNB) + L * CCH, 0); }
    RPT(15) if (EN(15) && IN(P + 2)) { SITE fft_stage_a(F); }
    SEAM(P + 2);
    if (EN(23) && IN(P + 3)) { SITE
        SchedFftC S{G, cid, (const char*)(ws + WS_DFTC), (const char*)(ws + DY_Z)};
        pg8::gemm_phase(ring, F.wave, pg8::GemmK{512, 4096, 512}, S, EpiFftC{(bf16*)(ws + DY_M) + 768}); }
    if (EN(5) && IN(P + 3)) { SITE t5_pass(F, inp(IQNG) + L * QKH, inp(IKNG) + L * QKH); } SEAM(P + 3);
    RPT(6) if (EN(6) && IN(P + 4)) { SITE
        const bf16* Q = (const bf16*)(ws + DY_Q); const bf16* K = (const bf16*)(ws + DY_K); const bf16* V = (const bf16*)(ws + DY_KV); bf16* O = (bf16*)(ws + DY_M);
        float mq, mk; { const int ln = lane_id(); const float* gq = inp(IQNG) + L * QKH; const float* gk = inp(IKNG) + L * QKH;
            float a = fmaxf(fabsf(gq[ln]), ln < 32 ? fabsf(gq[64 + ln]) : 0.f), b = fmaxf(fabsf(gk[ln]), ln < 32 ? fabsf(gk[64 + ln]) : 0.f);
#pragma unroll
            for (int o = 1; o < 64; o <<= 1) { a = fmaxf(a, __shfl_xor(a, o)); b = fmaxf(b, __shfl_xor(b, o)); }
            mq = __builtin_bit_cast(float, __builtin_amdgcn_readfirstlane(__builtin_bit_cast(int, a))); mk = __builtin_bit_cast(float, __builtin_amdgcn_readfirstlane(__builtin_bit_cast(int, b))); }
        const float B = 1.02f * 1.4426950408889634f * 9.797958971132712f * mq * mk; const bool fixed = B <= 60.0f; const float negB = fixed ? -B : 0.f;
        for (int u = cid; u < 512; u += G) { const int b = u >> 6, hh = (u >> 3) & 7, qb = u & 7; att::attn_unit(Q, K, V, O, b * SEQ + qb * 256, hh, 36, 32, b * SEQ, RX + b * CTXL, (LAS char*)ring, F.wave, negB, fixed, inp(IQNG) + L * QKH, (const float*)(ws + WS_ROPE) + (size_t)qb * 256 * 32); }
        if (L == 0) { for (int u = cid; u < 64; u += G) { const int b = u >> 3, hh = u & 7; att::attn_unit(Q, K, V, O, RX + b * CTXL, hh, 4, 0, 0, RX + b * CTXL, (LAS char*)ring, F.wave, negB, fixed, inp(IQNG) + L * QKH, nullptr); } }
    }
    SEAM(P + 4);
    if (EN(7) && IN(P + 5)) { SITE
        SchedResid<DM> S{G, cid, 0, L == 0 ? 72 : 64, (const char*)(ws + DY_M), (const char*)(ws + WS_WOUT) + (size_t)L * DM * DM * 2};
        EpiResid E{L == 0 ? inp(IX) : ((float*)(GAS float*)a.out), L == 0 ? inp(ICTX) : (const float*)(ws + WS_CTXS), ((float*)(GAS float*)a.out), (float*)(ws + WS_CTXS), modp(ws, L, 0, 2)};
        pg8::gemm_phase(ring, F.wave, pg8::GemmK{DM, DM, DM}, S, E);
        if (L == 0 && G == 256 && cid >= 32) {
            const int ln = lane_id();
            for (int j = 0; j < 3; ++j) transpose_item(ws, TT_ALL - FILL_P7 + ((cid - 32) * 8 + F.wave) * 3 + j, (LAS float*)F.lds + F.wave * 4096, ln); }
        if (L == 0 && G != 256) { const int ln = lane_id(); for (int it = TT_ALL - FILL_P7 + F.gw; it < TT_ALL; it += F.NGW) transpose_item(ws, it, (LAS float*)F.lds + F.wave * 4096, ln); }
    } SEAM(P + 5);
}
template <int K>
__device__ __forceinline__ void moe_round(const Args& a, Frame& F, const XcdBarrier& bar, const int lo, const int hi) {
    constexpr int rep_ = 0; (void)rep_;
    constexpr int P = K == 0 ? 18 : 21;
    LAS unsigned char* ring = F.lds;
    if (K == 0) { RPT(12) if (EN(12) && IN(P + 0)) { SITE moe_assign(F, 0); } SEAM(P + 0); }
    RPT(13) if (EN(13) && IN(P + 1)) { SITE
        SchedMoe<0> S{G, cid, (const int*)(ws + WS_MOE + MO_META) + 16 * K, ws};
        pg8::gemm_phase(ring, F.wave, pg8::GemmK{DM, DM, DM}, S, EpiPlain<DFF, true>{(bf16*)(ws + DY_ACT)});
    } SEAM(P + 1);
    if (EN(14) && IN(P + 2)) { SITE
        SchedMoe<2> S{G, cid, (const int*)(ws + WS_MOE + MO_META) + 16 * K, ws};
        EpiMoeDown E{(const int*)(ws + WS_MOE + MO_SROW) + K * 32768, (const float*)(ws + WS_MOE + MO_SW) + K * 32768, modp(ws, 1, 0, 5), ((float*)(GAS float*)a.out)};
        pg8::gemm_phase(ring, F.wave, pg8::GemmK{DFF, DFF, DFF}, S, E);
    }
    if (EN(19) && IN(P + 2)) { SITE
        SchedMoe<1> S{G, cid, (const int*)(ws + WS_MOE + MO_META) + 16 * K, ws};
        pg8::gemm_phase(ring, F.wave, pg8::GemmK{DM, DM, DM}, S, EpiPlain<DFF, true>{(bf16*)(ws + DY_ACT)});
    } SEAM(P + 2);
    if (EN(20) && IN(P + 3)) { SITE
        SchedMoe<3> S{G, cid, (const int*)(ws + WS_MOE + MO_META) + 16 * K, ws};
        EpiMoeDown E{(const int*)(ws + WS_MOE + MO_SROW) + K * 32768, (const float*)(ws + WS_MOE + MO_SW) + K * 32768, modp(ws, 1, 0, 5), ((float*)(GAS float*)a.out)};
        pg8::gemm_phase(ring, F.wave, pg8::GemmK{DFF, DFF, DFF}, S, E);
    }
    if (K == 0) { if (EN(12) && IN(P + 3)) { SITE moe_assign(F, 1); } }
    SEAM(P + 3);
}

__global__ void __launch_bounds__(512, 2) fwd(Args a) {
    extern __shared__ __attribute__((aligned(16))) unsigned char lds_raw[];
    Frame F;
    F.lds = (LAS unsigned char*)lds_raw; F.MISC = (volatile LAS unsigned*)(F.lds + MISC_OFF);
    F.wave = __builtin_amdgcn_readfirstlane((int)threadIdx.x >> 6);
    F.G = gridDim.x; F.gw = blockIdx.x * 8 + F.wave; F.NGW = F.G * 8; F.ws = a.ws; F.out = a.out;
    F.ctl = (gu32*)(a.ws + WS_CTL);
    for (int u = F.wave * 64 + lane_id(); u < (LDS_BYTES - LDSCTL_OFF) / 4; u += 512) ((LAS unsigned*)(F.lds + LDSCTL_OFF))[u] = 0u;
    __syncthreads();
    XcdBarrier bar; bar.bar = (unsigned*)(F.ctl + CW_BAR); bar.x = 0; bar.st = nullptr; bar.wave = F.wave;
    if (!MK_PER_PHASE) bar = xcd_barrier_post((unsigned*)(F.ctl + CW_BAR), F.MISC + 8, F.wave);
    const int lo = a.ph_lo, hi = a.ph_hi;
    LAS unsigned char* ring = F.lds;
    constexpr int rep_ = 0; (void)rep_;

    RPT(0) if (EN(0) && IN(0)) { if (PROBE_SITE >= 0 && rep_ > 0) xcd_barrier(bar); prologue(a, F); } SEAM(0);
    mixer_phases<0>(a, F, bar, lo, hi);
    RPT(8) if (EN(8) && IN(7)) { SITE adaln_pass<false>(F, 0, 3, inp(IFFNG), ((float*)(GAS float*)a.out), (const float*)(ws + WS_CTXS), true, nullptr); } SEAM(7);
    RPT(9) if (EN(9) && IN(8)) { SITE
        SchedGUa S{G, cid, (const char*)(ws + DY_H), (const char*)(ws + WS_WGU)};
        pg8::gemm_phase(ring, F.wave, pg8::GemmK{DM, DM, DM}, S, EpiPlain<DFF, true>{(bf16*)(ws + DY_ACT)});
    } SEAM(8);
    if (EN(10) && IN(9)) { SITE
        SchedResid<DFF> S{G, cid, 64, 8, (const char*)(ws + DY_ACT), (const char*)(ws + WS_WD)};
        EpiResid E{((float*)(GAS float*)a.out), (const float*)(ws + WS_CTXS), ((float*)(GAS float*)a.out), (float*)(ws + WS_CTXS), modp(ws, 0, 0, 5)};
        pg8::gemm_phase(ring, F.wave, pg8::GemmK{DFF, DFF, DFF}, S, E);
    }
    if (EN(21) && IN(9)) { SITE
        SchedGUb S{G, cid, (const char*)(ws + DY_H), (const char*)(ws + WS_WGU)};
        pg8::gemm_phase(ring, F.wave, pg8::GemmK{DM, DM, DM}, S, EpiPlain<DFF, true>{(bf16*)(ws + DY_ACT)});
    } SEAM(9);
    if (EN(22) && IN(10)) { SITE
        SchedResid<DFF> S{G, cid, 0, 64, (const char*)(ws + DY_ACT), (const char*)(ws + WS_WD)};
        EpiResid E{((float*)(GAS float*)a.out), (const float*)(ws + WS_CTXS), ((float*)(GAS float*)a.out), (float*)(ws + WS_CTXS), modp(ws, 0, 0, 5)};
        pg8::gemm_phase(ring, F.wave, pg8::GemmK{DFF, DFF, DFF}, S, E);
    } SEAM(10);
    mixer_phases<1>(a, F, bar, lo, hi);
    RPT(11) if (EN(11) && IN(17)) { SITE adaln_pass<true>(F, 1, 3, inp(IFFNG) + DM, ((float*)(GAS float*)a.out), nullptr, false, inp(IRW)); } SEAM(17);
    moe_round<0>(a, F, bar, lo, hi);
    moe_round<1>(a, F, bar, lo, hi);
}
#undef IN
#undef SEAM
#undef SITE

extern "C" void kernel_launch(void* const* d_in, const int* in_sizes, int n_in, void* d_out, int out_size, void* d_ws, size_t ws_size, hipStream_t stream) {
    static int grid = 0;
    if (grid == 0) {
        if (n_in != N_IN || out_size != RX * DM || ws_size < WS_END) { fprintf(stderr, "kernel_launch: unexpected shapes (n_in %d out %d ws %zu, need ws >= %zu)\n", n_in, out_size, ws_size, (size_t)WS_END); grid = -1; return; }
        int dev = 0, cus = 0, per_cu = 0;
        if (hipGetDevice(&dev) != hipSuccess || hipDeviceGetAttribute(&cus, hipDeviceAttributeMultiprocessorCount, dev) != hipSuccess) { grid = -1; return; }
        if (hipFuncSetAttribute((const void*)fwd, hipFuncAttributeMaxDynamicSharedMemorySize, LDS_BYTES) != hipSuccess) { fprintf(stderr, "kernel_launch: hipFuncSetAttribute failed\n"); grid = -1; return; }
        if (hipOccupancyMaxActiveBlocksPerMultiprocessor(&per_cu, (const void*)fwd, 512, LDS_BYTES) != hipSuccess || per_cu < 1) fprintf(stderr, "kernel_launch: occupancy query reports %d\n", per_cu);
        (void)hipGetLastError();
        grid = cus;
    }
    if (grid < 0) return;
    (void)hipMemsetAsync((char*)d_ws + WS_CTL, 0, CTL_ZERO_BYTES, stream);
    Args a{};
    for (int i = 0; i < N_IN; ++i) a.in[i] = (const float*)d_in[i];
    a.out = (float*)d_out; a.ws = (unsigned char*)d_ws;
#if MK_PER_PHASE
    for (int p = 0; p < N_PHASES; ++p) { a.ph_lo = p; a.ph_hi = p + 1; hipLaunchKernelGGL(fwd, dim3(grid), dim3(512), LDS_BYTES, stream, a); }
#else
    a.ph_lo = 0; a.ph_hi = N_PHASES;
    hipLaunchKernelGGL(fwd, dim3(grid), dim3(512), LDS_BYTES, stream, a);
#endif
}
```

```cpp
#include <hip/hip_runtime.h>
#include <cstdio>
#include <cstdint>

#ifndef MK_PER_PHASE
#define MK_PER_PHASE 0
#endif

#define GAS __attribute__((address_space(1)))
#define LAS __attribute__((address_space(3)))
typedef unsigned short bf16;
typedef short bf16x8 __attribute__((ext_vector_type(8)));
typedef short s16x4 __attribute__((ext_vector_type(4)));
typedef float f32x4 __attribute__((ext_vector_type(4)));
typedef float f32x2 __attribute__((ext_vector_type(2)));
typedef float f32x16 __attribute__((ext_vector_type(16)));
typedef unsigned u32x4 __attribute__((ext_vector_type(4)));
typedef unsigned u32x2 __attribute__((ext_vector_type(2)));
typedef GAS unsigned gu32;

constexpr int DM = 1024, NB = 8, SEQ = 2048, CTXL = 256, NH = 8, QKN = 64, QKR = 32, QKH = 96, VH = 64;
constexpr int QL = 384, KVL = 256, CCH = 256, CWID = 31, FCH = 256, INC = 1440, DFF = 2816, NE = 8;
constexpr int RX = NB * SEQ, RC = NB * CTXL, RT = RX + RC;
constexpr int OFF_CKV = 384, OFF_KR = 640, OFF_CONV = 672, OFF_FOUR = 1184;
constexpr int NCOL = 1280;
constexpr int NC3 = 768;
constexpr int C_KR = 384, C_CKV = 512;
constexpr float EPS = 1e-6f;
constexpr int NSLOT = RX + NE * 256;
constexpr int N_PHASES = 25;

constexpr size_t MiB = 1u << 20;
constexpr size_t WS_CTL = 0, CTL_ZERO_BYTES = 1 * MiB;
constexpr size_t WS_MOD = 1 * MiB;
constexpr size_t WS_ROPE = 2 * MiB;
constexpr size_t WS_MOE = 3 * MiB;
constexpr size_t WS_DFTC = 5 * MiB;
constexpr size_t WS_WUQ = 6 * MiB;
constexpr size_t WS_WUKV = 8 * MiB;
constexpr size_t WS_WIN = 10 * MiB;
constexpr size_t WS_WFT = 15 * MiB;
constexpr size_t WS_WOUT = 17 * MiB;
constexpr size_t WS_WGU = 21 * MiB;
constexpr size_t WS_WD = 32 * MiB;
constexpr size_t WS_SSQP = 38 * MiB;
constexpr size_t WS_MOEGU = 54 * MiB;
constexpr size_t WS_MOED = 142 * MiB;
constexpr size_t WS_CTXS = 186 * MiB;
constexpr size_t WS_DYN = 194 * MiB;
constexpr size_t DY_C = WS_DYN;
constexpr size_t DY_Z = DY_C + 45 * MiB;
constexpr size_t DY_Q = DY_Z + 18 * MiB;
constexpr size_t DY_KV = DY_Q + 27 * MiB;
constexpr size_t DY_M = DY_KV + 36 * MiB;
constexpr size_t DY_H = DY_M + 36 * MiB;
constexpr size_t WS_END = DY_H + 36 * MiB;
constexpr size_t DY_ACT = DY_C;
constexpr size_t DY_Y = DY_C + 27 * MiB, DY_K = DY_H;
static_assert(DY_ACT + (size_t)RT * DFF * 2 <= DY_M, "act overlay");
constexpr size_t MO_CNT = 0;
constexpr size_t MO_META = 64 * 1024;
constexpr size_t MO_TOKE = 128 * 1024;
constexpr size_t MO_TOKW = 256 * 1024;
constexpr size_t MO_SROW = 512 * 1024;
constexpr size_t MO_SW = 768 * 1024;

constexpr int CW_TMO = 0, CW_BAR = 4096;

constexpr int RING_BYTES = 131072;
constexpr int LDSCTL_OFF = RING_BYTES, MISC_OFF = LDSCTL_OFF + 320;
constexpr int LDS_BYTES = 147456;

#define RLX_AGENT __ATOMIC_RELAXED, __HIP_MEMORY_SCOPE_AGENT
#define LDS_WAIT() asm volatile("s_waitcnt lgkmcnt(0)" ::: "memory")
#define VM_WAIT() asm volatile("s_waitcnt vmcnt(0)" ::: "memory")
__device__ __forceinline__ unsigned f2bf(float f) { unsigned u = __builtin_bit_cast(unsigned, f); return (u + 0x7fffu + ((u >> 16) & 1u)) >> 16; }
__device__ __forceinline__ unsigned pk2(float lo, float hi) { return f2bf(lo) | (f2bf(hi) << 16); }
__device__ __forceinline__ float bflo(unsigned w) { return __builtin_bit_cast(float, w << 16); }
__device__ __forceinline__ float bfhi(unsigned w) { return __builtin_bit_cast(float, w & 0xffff0000u); }
__device__ __forceinline__ float bf1(bf16 v) { return __builtin_bit_cast(float, (unsigned)v << 16); }
__device__ __forceinline__ unsigned cvt_pk_bf16(float lo, float hi) { unsigned r; asm volatile("v_cvt_pk_bf16_f32 %0, %1, %2" : "=v"(r) : "v"(lo), "v"(hi)); return r; }
template <int CTRL> __device__ __forceinline__ float dpp_f(float v) { return __builtin_bit_cast(float, __builtin_amdgcn_update_dpp(0, __builtin_bit_cast(int, v), CTRL, 0xf, 0xf, true)); }
__device__ __forceinline__ float sum8(float v) {
    v += dpp_f<0xB1>(v);
    v += dpp_f<0x4E>(v);
    v += dpp_f<0x141>(v);
    return v;
}
__device__ __forceinline__ float wave_sum(float v) {
    v = sum8(v);
    v += dpp_f<0x140>(v);
    { auto r = __builtin_amdgcn_permlane16_swap(__float_as_uint(v), __float_as_uint(v), false, false); v = __uint_as_float(r[0]) + __uint_as_float(r[1]); }
    { auto r = __builtin_amdgcn_permlane32_swap(__float_as_uint(v), __float_as_uint(v), false, false); v = __uint_as_float(r[0]) + __uint_as_float(r[1]); }
    return v;
}
template <int CTRL> __device__ __forceinline__ int dpp_i(int v) { return __builtin_amdgcn_update_dpp(0, v, CTRL, 0xf, 0xf, true); }
__device__ __forceinline__ int wave_isum(int v) {
    v += dpp_i<0xB1>(v); v += dpp_i<0x4E>(v); v += dpp_i<0x141>(v); v += dpp_i<0x140>(v);
    { auto r = __builtin_amdgcn_permlane16_swap((unsigned)v, (unsigned)v, false, false); v = (int)(r[0] + r[1]); }
    { auto r = __builtin_amdgcn_permlane32_swap((unsigned)v, (unsigned)v, false, false); v = (int)(r[0] + r[1]); }
    return v;
}
__device__ __forceinline__ float sigmoidf_(float x) { return 1.0f / (1.0f + __expf(-x)); }
__device__ __forceinline__ float siluf_(float x) { return x / (1.0f + __expf(-x)); }

__device__ __forceinline__ int lane_id() { int l; asm volatile("v_mbcnt_lo_u32_b32 %0, -1, 0\n\tv_mbcnt_hi_u32_b32 %0, -1, %0" : "=v"(l)); return l; }
#define XB_TMO      128
#define XB_XCNT(j)  (256  + 64 * (j))
#define XB_XSUB(j)  (1280 + 64 * (j))
#define XB_XGEN(j)  (2304 + 64 * (j))
#define XB_TOP      3328
#define XB_TOPGEN   3392
#define XCD_BAR_WORDS 3456
#define XB_SPIN_CAP (1u << 18)
__device__ __forceinline__ unsigned xb_ld(unsigned* p)              { return __hip_atomic_load(p, __ATOMIC_RELAXED, __HIP_MEMORY_SCOPE_AGENT); }
__device__ __forceinline__ unsigned xb_add(unsigned* p, unsigned v) { return __hip_atomic_fetch_add(p, v, __ATOMIC_RELAXED, __HIP_MEMORY_SCOPE_AGENT); }
__device__ __forceinline__ unsigned xb_xcc_id() { return (unsigned)__builtin_amdgcn_s_getreg((3 << 11) | 20) & 0xFu; }
#define XB_SPIN(cond, bar) do { unsigned _sp = 0; while (cond) { __builtin_amdgcn_s_sleep(1); \
    if ((++_sp & 255u) == 0u) { if (xb_ld(&(bar)[XB_TMO])) break; if (_sp > XB_SPIN_CAP) { atomicAdd(&(bar)[XB_TMO], 1u); break; } } } } while (0)
struct XcdBarrier { unsigned* bar; unsigned x; volatile LAS unsigned* st; int wave; };
__device__ __forceinline__ XcdBarrier xcd_barrier_post(unsigned* bar, volatile LAS unsigned* st, int wave) {
    XcdBarrier b; b.bar = bar; b.x = xb_xcc_id(); b.st = st; b.wave = wave;
    if (wave == 0 && lane_id() == 0) (void)xb_add(&bar[XB_XCNT(b.x)], 1u);
    return b;
}
__device__ __forceinline__ void xcd_barrier_complete(unsigned* bar, unsigned x, unsigned& nloc, unsigned& nx) {
    const unsigned G = gridDim.x * gridDim.y * gridDim.z;
    unsigned sum, cnt, mine, sp = 0u;
    for (;;) {
        sum = 0u; cnt = 0u; mine = 0u;
#pragma nounroll
        for (unsigned j = 0; j < 16; ++j) { const unsigned c = xb_ld(&bar[XB_XCNT(j)]); sum += c; cnt += (c > 0u) ? 1u : 0u; mine = (j == x) ? c : mine; }
        if (sum == G) break;
        __builtin_amdgcn_s_sleep(1);
        if ((++sp & 255u) == 0u) { if (xb_ld(&bar[XB_TMO])) break; if (sp > XB_SPIN_CAP) { atomicAdd(&bar[XB_TMO], 1u); break; } }
    }
    nloc = mine > 0u ? mine : 1u; nx = cnt > 0u ? cnt : 1u;
}
__device__ __forceinline__ void xcd_barrier(const XcdBarrier& b) {
    asm volatile("s_waitcnt vmcnt(0)" ::: "memory");
    __syncthreads();
    if (b.wave == 0 && lane_id() == 0) {
        unsigned* bar = b.bar;
        __builtin_amdgcn_s_waitcnt(0);
        unsigned nloc = b.st[0], nx = b.st[1];
        if (nloc == 0u) { xcd_barrier_complete(bar, b.x, nloc, nx); b.st[0] = nloc; b.st[1] = nx; }
        const unsigned old = xb_add(&bar[XB_XSUB(b.x)], 1u);
        const unsigned gen = old / nloc;
        if (old + 1u == (gen + 1u) * nloc) {
            __builtin_amdgcn_fence(__ATOMIC_RELEASE, "agent");
            asm volatile("s_waitcnt vmcnt(0)" ::: "memory");
            const unsigned og = xb_add(&bar[XB_TOP], 1u);
            const unsigned tg = og / nx;
            if (og + 1u == (tg + 1u) * nx) xb_add(&bar[XB_TOPGEN], 1u);
            else XB_SPIN(xb_ld(&bar[XB_TOPGEN]) == tg, bar);
            __builtin_amdgcn_fence(__ATOMIC_ACQUIRE, "agent");
            xb_add(&bar[XB_XGEN(b.x)], 1u);
            asm volatile("s_waitcnt vmcnt(0)" ::: "memory");
        } else {
            XB_SPIN(xb_ld(&bar[XB_XGEN(b.x)]) == gen, bar);
            __builtin_amdgcn_fence(__ATOMIC_ACQUIRE, "agent");
            asm volatile("s_waitcnt vmcnt(0)" ::: "memory");
        }
    }
    __syncthreads();
}

namespace pg8 {
constexpr int BM = 256, BK = 64, HALF = 128, HTB = HALF * BK * 2, STAGE_BYTES = 8 * HTB;
__host__ __device__ __forceinline__ int lds_byte(int r, int c) { const int st = (r >> 4) * 2 + (c >> 5), rr = r & 15, cc = c & 31, ob = rr * 64 + cc * 2; return st * 1024 + (ob ^ (((ob >> 9) & 1) << 5)); }
__host__ __device__ __forceinline__ void stage_rc(int b, int& R, int& C) { const int st = b / 1024, sb = b % 1024, swz = sb ^ (((sb >> 9) & 1) << 5); R = (st >> 1) * 16 + swz / 64; C = (st & 1) * 32 + (swz % 64) / 2; }
__host__ __device__ __forceinline__ int perm32(int rho) { const int n = rho >> 4, i = rho & 15; return 8 * (i >> 2) + 4 * n + (i & 3); }

struct Unit { int pm, pn; };
struct GemmK { int lda, ldb, K; };

__device__ __forceinline__ void store_tile_bf16(const f32x4 (&acc)[2][2][4][2], bf16* C, int ldc, int wr, int wc, int fr, int fq) {
    const unsigned off0 = (unsigned)((wr * 64 + fr) * ldc + wc * 32 + 8 * fq) * 2u;
#pragma unroll
    for (int ai = 0; ai < 2; ++ai)
#pragma unroll
        for (int m = 0; m < 4; ++m) { const unsigned offr = off0 + (unsigned)((ai * HALF + m * 16) * ldc) * 2u;
#pragma unroll
            for (int bj = 0; bj < 2; ++bj) { const f32x4 v0 = acc[ai][bj][m][0], v1 = acc[ai][bj][m][1];
                u32x4 w; w.x = cvt_pk_bf16(v0[0], v0[1]); w.y = cvt_pk_bf16(v0[2], v0[3]); w.z = cvt_pk_bf16(v1[0], v1[1]); w.w = cvt_pk_bf16(v1[2], v1[3]);
                *(u32x4*)((char*)C + (offr + (unsigned)(bj * HALF * 2))) = w; } }
}
__device__ __forceinline__ void store_tile_swiglu(const f32x4 (&acc)[2][2][4][2], bf16* C, int ldc, int wr, int wc, int fr, int fq) {
    const unsigned off0 = (unsigned)((wr * 64 + fr) * ldc + wc * 32 + 8 * fq) * 2u;
#pragma unroll
    for (int ai = 0; ai < 2; ++ai)
#pragma unroll
        for (int m = 0; m < 4; ++m) { const unsigned offr = off0 + (unsigned)((ai * HALF + m * 16) * ldc) * 2u;
            float o[8];
#pragma unroll
            for (int n = 0; n < 2; ++n)
#pragma unroll
                for (int e = 0; e < 4; ++e) { const float g = acc[ai][0][m][n][e], up = acc[ai][1][m][n][e]; o[n * 4 + e] = g * __builtin_amdgcn_rcpf(1.0f + __expf(-g)) * up; }
            u32x4 w; w.x = cvt_pk_bf16(o[0], o[1]); w.y = cvt_pk_bf16(o[2], o[3]); w.z = cvt_pk_bf16(o[4], o[5]); w.w = cvt_pk_bf16(o[6], o[7]);
            *(u32x4*)((char*)C + offr) = w; }
}
__device__ __forceinline__ void store_tile_resid(const f32x4 (&acc)[2][2][4][2], const float* X, float* C, const float* gvp, int wr, int wc, int fr, int fq) {
    const int col0 = wc * 32 + 4 * fq;
    f32x4 gv[2][2];
#pragma unroll
    for (int bj = 0; bj < 2; ++bj)
#pragma unroll
        for (int n = 0; n < 2; ++n) gv[bj][n] = *(const f32x4*)((const char*)gvp + (unsigned)(col0 + bj * HALF + n * 16) * 4u);
    const unsigned off0 = (unsigned)((wr * 64 + fr) * DM + col0) * 4u;
#pragma unroll
    for (int ai = 0; ai < 2; ++ai)
#pragma unroll
        for (int m = 0; m < 4; ++m) { const unsigned offr = off0 + (unsigned)((ai * HALF + m * 16) * DM) * 4u;
#pragma unroll
            for (int bj = 0; bj < 2; ++bj)
#pragma unroll
                for (int n = 0; n < 2; ++n) { const unsigned o = offr + (unsigned)(bj * HALF + n * 16) * 4u; const f32x4 xv = *(const f32x4*)((const char*)X + o); *(f32x4*)((char*)C + o) = xv + gv[bj][n] * acc[ai][bj][m][n]; } }
}

template <int NP>
__device__ __forceinline__ void store_tile_bf16_rs(const f32x4 (&acc)[2][2][4][2], bf16* C, int ldc, const float* part, float inv_k, int wr, int wc, int fr, int fq) {
    const unsigned off0 = (unsigned)((wr * 64 + fr) * ldc + wc * 32 + 8 * fq) * 2u;
#pragma unroll
    for (int ai = 0; ai < 2; ++ai)
#pragma unroll
        for (int m = 0; m < 4; ++m) { const unsigned offr = off0 + (unsigned)((ai * HALF + m * 16) * ldc) * 2u;
            const float* pr = part + (size_t)(ai * HALF + wr * 64 + m * 16 + fr) * 12; float ss;
            { const f32x4 p0 = *(const f32x4*)pr; ss = (p0.x + p0.y) + (p0.z + p0.w); if (NP == 8) { const f32x4 p1 = *(const f32x4*)(pr + 4); ss += (p1.x + p1.y) + (p1.z + p1.w); } }
            const float rs = 1.0f / sqrtf(ss * inv_k + EPS);
#pragma unroll
            for (int bj = 0; bj < 2; ++bj) { const f32x4 v0 = acc[ai][bj][m][0] * rs, v1 = acc[ai][bj][m][1] * rs;
                u32x4 w; w.x = cvt_pk_bf16(v0[0], v0[1]); w.y = cvt_pk_bf16(v0[2], v0[3]); w.z = cvt_pk_bf16(v1[0], v1[1]); w.w = cvt_pk_bf16(v1[2], v1[3]);
                *(u32x4*)((char*)C + (offr + (unsigned)(bj * HALF * 2))) = w; } }
}
template <int NBJ>
__device__ __forceinline__ void store_tile_bf16_ssq(const f32x4 (&acc)[2][2][4][2], bf16* C, int ldc, float* part, int wr, int wc, int fr, int fq) {
    const unsigned off0 = (unsigned)((wr * 64 + fr) * ldc + wc * 32 + 8 * fq) * 2u;
#pragma unroll
    for (int ai = 0; ai < 2; ++ai)
#pragma unroll
        for (int m = 0; m < 4; ++m) { const unsigned offr = off0 + (unsigned)((ai * HALF + m * 16) * ldc) * 2u; float sq = 0.f;
#pragma unroll
            for (int bj = 0; bj < 2; ++bj) { const f32x4 v0 = acc[ai][bj][m][0], v1 = acc[ai][bj][m][1];
                u32x4 w; w.x = cvt_pk_bf16(v0[0], v0[1]); w.y = cvt_pk_bf16(v0[2], v0[3]); w.z = cvt_pk_bf16(v1[0], v1[1]); w.w = cvt_pk_bf16(v1[2], v1[3]);
                *(u32x4*)((char*)C + (offr + (unsigned)(bj * HALF * 2))) = w;
                if (bj < NBJ) { float a;
                    a = bflo(w.x); sq += a * a; a = bfhi(w.x); sq += a * a; a = bflo(w.y); sq += a * a; a = bfhi(w.y); sq += a * a;
                    a = bflo(w.z); sq += a * a; a = bfhi(w.z); sq += a * a; a = bflo(w.w); sq += a * a; a = bfhi(w.w); sq += a * a; } }
            { auto r = __builtin_amdgcn_permlane16_swap(__float_as_uint(sq), __float_as_uint(sq), false, false); sq = __uint_as_float(r[0]) + __uint_as_float(r[1]); }
            { auto r = __builtin_amdgcn_permlane32_swap(__float_as_uint(sq), __float_as_uint(sq), false, false); sq = __uint_as_float(r[0]) + __uint_as_float(r[1]); }
            if (fq == 0) part[(size_t)(ai * HALF + wr * 64 + m * 16 + fr) * 12] = sq; }
}
__device__ __forceinline__ void store_tile_glu(const f32x4 (&acc)[2][2][4][2], bf16* C, int ldc, int wr, int wc, int fr, int fq) {
    const unsigned off0 = (unsigned)((wr * 64 + fr) * ldc + wc * 32 + 8 * fq) * 2u;
#pragma unroll
    for (int ai = 0; ai < 2; ++ai)
#pragma unroll
        for (int m = 0; m < 4; ++m) { const unsigned offr = off0 + (unsigned)((ai * HALF + m * 16) * ldc) * 2u;
            float o[8];
#pragma unroll
            for (int n = 0; n < 2; ++n)
#pragma unroll
                for (int e = 0; e < 4; ++e) { const float av = acc[ai][0][m][n][e], g = acc[ai][1][m][n][e]; o[n * 4 + e] = av * __builtin_amdgcn_rcpf(1.0f + __expf(-g)); }
            u32x4 w; w.x = cvt_pk_bf16(o[0], o[1]); w.y = cvt_pk_bf16(o[2], o[3]); w.z = cvt_pk_bf16(o[4], o[5]); w.w = cvt_pk_bf16(o[6], o[7]);
            *(u32x4*)((char*)C + offr) = w; }
}

template <class Epi, class Sched>
__device__ __forceinline__ void gemm_phase(LAS unsigned char* lds, const int wave, const GemmK g, const Sched& S, const Epi& E) {
    int tid = wave * 64 + lane_id(); asm volatile("" : "+v"(tid));
    const int wid = wave, lane = tid & 63, wr = wid >> 2, wc = wid & 3, fr = lane & 15, fq = lane >> 4;
    const int nt = g.K / BK;
    unsigned voffA[2], voffB[2];
#pragma unroll
    for (int i = 0; i < 2; ++i) { int R, C; stage_rc(tid * 16 + i * 8192, R, C); const int Rb = Epi::PERM ? ((R & ~31) + perm32(R & 31)) : R;
        voffA[i] = (unsigned)(R * g.lda + C) * 2u; voffB[i] = (unsigned)(Rb * g.ldb + C) * 2u; }
    const size_t kstep = (size_t)(BK * 2);
    const size_t hsA = (size_t)HALF * g.lda * 2, hsB = (size_t)HALF * g.ldb * 2;
    const unsigned ldsw = (unsigned)wid * 1024u;
    const int aoff = lds_byte(wr * 64 + fr, fq * 8), boff = lds_byte(wc * 32 + fr, fq * 8);
#define PG8_SA(b, h) (((b) * 2 + (h)) * HTB)
#define PG8_SB(b, h) ((4 + (b) * 2 + (h)) * HTB)
#define PG8_STAGE(bufoff, gbase, voff) do { _Pragma("unroll") for (int _i = 0; _i < 2; ++_i) \
        __builtin_amdgcn_global_load_lds((const unsigned*)((const char*)(gbase) + (voff)[_i]), (LAS unsigned*)(lds + (bufoff) + ldsw + _i * 8192), 16, 0, 0); } while (0)
#define PG8_LDA(dst, b, h) do { _Pragma("unroll") for (int m = 0; m < 4; ++m) _Pragma("unroll") for (int k = 0; k < 2; ++k) dst[m][k] = *(const LAS bf16x8*)(lds + PG8_SA(b, h) + aoff + m * 2048 + k * 1024); } while (0)
#define PG8_LDB(dst, b, h) do { _Pragma("unroll") for (int n = 0; n < 2; ++n) _Pragma("unroll") for (int k = 0; k < 2; ++k) dst[n][k] = *(const LAS bf16x8*)(lds + PG8_SB(b, h) + boff + n * 2048 + k * 1024); } while (0)
#define PG8_MMA(ai, bj, At, Bt) do { __builtin_amdgcn_s_setprio(1); _Pragma("unroll") for (int m = 0; m < 4; ++m) _Pragma("unroll") for (int n = 0; n < 2; ++n) _Pragma("unroll") for (int k = 0; k < 2; ++k) \
        acc[ai][bj][m][n] = __builtin_amdgcn_mfma_f32_16x16x32_bf16(Bt[n][k], At[m][k], acc[ai][bj][m][n], 0, 0, 0); __builtin_amdgcn_s_setprio(0); } while (0)
#define PG8_WAIT_V(n) asm volatile("s_waitcnt vmcnt(" #n ")" ::: "memory")
#define PG8_WAIT_L(n) asm volatile("s_waitcnt lgkmcnt(" #n ")" ::: "memory")
#define PG8_BAR __builtin_amdgcn_s_barrier()
#define PG8_SCHED __builtin_amdgcn_sched_barrier(0)
    Unit cur, nxt; int ui = 0;
    if (!S.next(0, cur)) return;
    f32x4 acc[2][2][4][2];
#pragma unroll
    for (int a = 0; a < 2; ++a)
#pragma unroll
        for (int b = 0; b < 2; ++b)
#pragma unroll
            for (int m = 0; m < 4; ++m)
#pragma unroll
                for (int n = 0; n < 2; ++n) acc[a][b][m][n] = (f32x4){0.f, 0.f, 0.f, 0.f};
    bf16x8 At[4][2], B0[2][2], B1[2][2];
    const char* cA = S.aptr(cur); const char* cB = S.bptr(cur);
    PG8_STAGE(PG8_SB(0, 0), cB, voffB); PG8_STAGE(PG8_SB(0, 1), cB + hsB, voffB); PG8_STAGE(PG8_SA(0, 0), cA, voffA); PG8_STAGE(PG8_SA(0, 1), cA + hsA, voffA);
    if (wr == 1) PG8_BAR;
    PG8_WAIT_V(2); PG8_BAR;
    PG8_STAGE(PG8_SB(1, 0), cB + kstep, voffB); PG8_STAGE(PG8_SA(1, 0), cA + kstep, voffA); PG8_STAGE(PG8_SB(1, 1), cB + hsB + kstep, voffB);
    PG8_WAIT_V(6); PG8_BAR;
    for (;;) {
        const bool has_next = S.next(ui + 1, nxt);
        const char* nA = has_next ? S.aptr(nxt) : cA; const char* nB = has_next ? S.bptr(nxt) : cB;
#pragma nounroll
        for (int t = 0; t < nt; t += 2) {
            const bool last = (t == nt - 2);
            const char* a1 = cA + (size_t)(t + 1) * kstep;
            const char* a2 = last ? nA : cA + (size_t)(t + 2) * kstep; const char* b2 = last ? nB : cB + (size_t)(t + 2) * kstep;
            const char* a3 = a2 + kstep; const char* b3 = b2 + kstep;
            PG8_LDB(B0, 0, 0); PG8_LDB(B1, 0, 1); PG8_SCHED; PG8_LDA(At, 0, 0); PG8_STAGE(PG8_SA(1, 1), a1 + hsA, voffA);
            PG8_WAIT_V(8); PG8_WAIT_L(0); PG8_BAR; PG8_MMA(0, 0, At, B0); PG8_MMA(0, 1, At, B1); PG8_BAR; PG8_SCHED;
            PG8_LDA(At, 0, 1); PG8_STAGE(PG8_SB(0, 0), b2, voffB); PG8_STAGE(PG8_SB(0, 1), b2 + hsB, voffB); PG8_STAGE(PG8_SA(0, 0), a2, voffA);
            PG8_WAIT_V(8); PG8_WAIT_L(0); PG8_BAR; PG8_MMA(1, 0, At, B0); PG8_MMA(1, 1, At, B1); PG8_BAR; PG8_SCHED;
            PG8_LDB(B0, 1, 0); PG8_LDB(B1, 1, 1); PG8_SCHED; PG8_LDA(At, 1, 0); PG8_STAGE(PG8_SA(0, 1), a2 + hsA, voffA);
            PG8_WAIT_V(8); PG8_WAIT_L(0); PG8_BAR; PG8_MMA(0, 0, At, B0); PG8_MMA(0, 1, At, B1); PG8_BAR; PG8_SCHED;
            PG8_LDA(At, 1, 1); PG8_STAGE(PG8_SB(1, 0), b3, voffB); PG8_STAGE(PG8_SB(1, 1), b3 + hsB, voffB); PG8_STAGE(PG8_SA(1, 0), a3, voffA);
            PG8_WAIT_V(8); PG8_WAIT_L(0); PG8_BAR; PG8_MMA(1, 0, At, B0); PG8_MMA(1, 1, At, B1); PG8_BAR; PG8_SCHED;
        }
        if (wr == 0) PG8_BAR;
        { int fr_ = fr, fq_ = fq; asm volatile("" : "+v"(fr_), "+v"(fq_));
          E(acc, cur, wr, wc, fr_, fq_); }
        if (!has_next) break;
#pragma unroll
        for (int a = 0; a < 2; ++a)
#pragma unroll
            for (int b = 0; b < 2; ++b)
#pragma unroll
                for (int m = 0; m < 4; ++m)
#pragma unroll
                    for (int n = 0; n < 2; ++n) acc[a][b][m][n] = (f32x4){0.f, 0.f, 0.f, 0.f};
        cur = nxt; cA = nA; cB = nB; ++ui;
        if (wr == 1) PG8_BAR;
    }
    PG8_WAIT_V(0);
    PG8_BAR;
#undef PG8_SA
#undef PG8_SB
#undef PG8_STAGE
#undef PG8_LDA
#undef PG8_LDB
#undef PG8_MMA
#undef PG8_WAIT_V
#undef PG8_WAIT_L
#undef PG8_BAR
#undef PG8_SCHED
}
}

namespace att {
constexpr int SHM_V = 64 * 64 * 2, SHM_K = 64 * 256;
constexpr int NSLOT = 3;
constexpr int LDS_V = 0, LDS_K = NSLOT * SHM_V, LDS_WS = NSLOT * SHM_V + NSLOT * SHM_K, LDS_TOTAL = LDS_WS + 8 * 64 * 4;
constexpr float THR2 = 11.5f;
#define KSWZ(row, colB) ((row) * 256 + ((colB) ^ (((row) & 7) << 4)))
#define SBAR() __builtin_amdgcn_sched_barrier(0)
__device__ __forceinline__ int crow(int r, int hi) { return (r & 3) + 8 * (r >> 2) + 4 * hi; }
__device__ __forceinline__ int v_st(int k, int c) { const int kk = (k & ~0xC) | ((k & 4) << 1) | ((k & 8) >> 1); return ((kk >> 3) * 2 + (c >> 5)) * 512 + ((kk & 7) * 32 + (c & 31)) * 2; }
__device__ __forceinline__ int v_rd_base(int lane) { return ((lane & 3) << 3) | (((lane >> 2) & 3) << 6) | (((lane >> 4) & 1) << 5) | (((lane >> 5) & 1) << 8); }
constexpr int v_rd_off(int d0, int ks, int half) { return d0 * 512 + ks * 2048 + half * 1024; }
template <int OFF> __device__ __forceinline__ s16x4 tr_read(int vb) {
    s16x4 r; asm volatile("ds_read_b64_tr_b16 %0, %1 offset:%2" : "=&v"(r) : "v"(vb), "i"(OFF) : "memory"); return r;
}
__device__ __forceinline__ void partialSM(f32x16& p0, f32x16& p1, float& m_reg, float& mn, float& alpha, const bool fixed) {
    if (!fixed) {
        float pmax = p0[0];
#pragma unroll
        for (int r = 1; r < 16; ++r) pmax = fmaxf(pmax, p0[r]);
#pragma unroll
        for (int r = 0; r < 16; ++r) pmax = fmaxf(pmax, p1[r]);
        { auto rr = __builtin_amdgcn_permlane32_swap(__float_as_uint(pmax), __float_as_uint(pmax), false, false);
          pmax = fmaxf(__uint_as_float(rr[0]), __uint_as_float(rr[1])); }
        if (__builtin_expect(__all(pmax - m_reg <= THR2), 1)) { mn = m_reg; alpha = 1.f; }
        else { mn = fmaxf(m_reg, pmax); alpha = __builtin_amdgcn_exp2f(m_reg - mn); m_reg = mn; }
#pragma unroll
        for (int r = 0; r < 16; ++r) p0[r] = p0[r] - mn;
#pragma unroll
        for (int r = 0; r < 16; ++r) p1[r] = p1[r] - mn;
    } else { mn = 0.f; alpha = 1.f; }
#pragma unroll
    for (int r = 0; r < 16; ++r) p0[r] = __builtin_amdgcn_exp2f(p0[r]);
}
__device__ __forceinline__ void finishSM(f32x16& p0, f32x16& p1, float alpha, float& l_reg, bf16x8& pa0, bf16x8& pa1, bf16x8& pa2, bf16x8& pa3) {
#pragma unroll
    for (int r = 0; r < 16; ++r) p1[r] = __builtin_amdgcn_exp2f(p1[r]);
    float ps = 0;
#pragma unroll
    for (int r = 0; r < 16; ++r) ps += p0[r];
#pragma unroll
    for (int r = 0; r < 16; ++r) ps += p1[r];
    { auto rr = __builtin_amdgcn_permlane32_swap(__float_as_uint(ps), __float_as_uint(ps), false, false);
      ps = __uint_as_float(rr[0]) + __uint_as_float(rr[1]); }
    l_reg = l_reg * alpha + ps;
#define PK4(P, BASE, OUT) do { unsigned a0 = cvt_pk_bf16(P[BASE + 0], P[BASE + 1]), a1 = cvt_pk_bf16(P[BASE + 2], P[BASE + 3]);   \
    unsigned b0 = cvt_pk_bf16(P[BASE + 4], P[BASE + 5]), b1 = cvt_pk_bf16(P[BASE + 6], P[BASE + 7]);                              \
    auto r0 = __builtin_amdgcn_permlane32_swap(a0, b0, false, false); auto r1 = __builtin_amdgcn_permlane32_swap(a1, b1, false, false); \
    u32x4 w = {r0[0], r1[0], r0[1], r1[1]}; OUT = __builtin_bit_cast(bf16x8, w); } while (0)
    PK4(p0, 0, pa0); PK4(p0, 8, pa1); PK4(p1, 0, pa2); PK4(p1, 8, pa3);
#undef PK4
}
__device__ __forceinline__ void qkt(f32x16& p0, f32x16& p1, const LAS char* Ks, const bf16x8* qr, int r32, int hi, const float c0) {
#pragma unroll
    for (int r = 0; r < 16; ++r) { p0[r] = c0; p1[r] = c0; }
#pragma unroll
    for (int d0 = 0; d0 < 6; ++d0) { const int cb = (d0 * 16 + hi * 8) * 2;
        const bf16x8 b0 = *(const LAS bf16x8*)(Ks + KSWZ(r32, cb));
        const bf16x8 b1 = *(const LAS bf16x8*)(Ks + KSWZ(32 + r32, cb));
        p0 = __builtin_amdgcn_mfma_f32_32x32x16_bf16(b0, qr[d0], p0, 0, 0, 0);
        p1 = __builtin_amdgcn_mfma_f32_32x32x16_bf16(b1, qr[d0], p1, 0, 0, 0); }
}
template <int D0> __device__ __forceinline__ void pv_one(f32x16& od, int vb, bf16x8 pa0, bf16x8 pa1, bf16x8 pa2, bf16x8 pa3) {
    const s16x4 l0 = tr_read<v_rd_off(D0, 0, 0)>(vb), h0 = tr_read<v_rd_off(D0, 0, 1)>(vb), l1 = tr_read<v_rd_off(D0, 1, 0)>(vb), h1 = tr_read<v_rd_off(D0, 1, 1)>(vb);
    const s16x4 l2 = tr_read<v_rd_off(D0, 2, 0)>(vb), h2 = tr_read<v_rd_off(D0, 2, 1)>(vb), l3 = tr_read<v_rd_off(D0, 3, 0)>(vb), h3 = tr_read<v_rd_off(D0, 3, 1)>(vb);
    asm volatile("s_waitcnt lgkmcnt(0)" ::: "memory"); SBAR();
#define PKV(L, H) (bf16x8){L[0], L[1], L[2], L[3], H[0], H[1], H[2], H[3]}
    od = __builtin_amdgcn_mfma_f32_32x32x16_bf16(pa0, PKV(l0, h0), od, 0, 0, 0);
    od = __builtin_amdgcn_mfma_f32_32x32x16_bf16(pa1, PKV(l1, h1), od, 0, 0, 0);
    od = __builtin_amdgcn_mfma_f32_32x32x16_bf16(pa2, PKV(l2, h2), od, 0, 0, 0);
    od = __builtin_amdgcn_mfma_f32_32x32x16_bf16(pa3, PKV(l3, h3), od, 0, 0, 0);
#undef PKV
}
__device__ __forceinline__ void pv_all(f32x16* o, int vb, bf16x8 pa0, bf16x8 pa1, bf16x8 pa2, bf16x8 pa3) {
    pv_one<0>(o[0], vb, pa0, pa1, pa2, pa3); pv_one<1>(o[1], vb, pa0, pa1, pa2, pa3);
}
__device__ __forceinline__ void attn_unit(const bf16* __restrict__ Q, const bf16* __restrict__ K, const bf16* __restrict__ V, bf16* __restrict__ O,
                                          int qrow0, int h, int NT, int nx, int kx0, int kc0, LAS char* lds, const int wave, const float negB, const bool fixed, const float* qgain, const float* qrope) {
    int tid = wave * 64 + lane_id(); asm volatile("" : "+v"(tid));
    const int wid = wave, lane = tid & 63, r32 = lane & 31, hi = lane >> 5;
    LAS char* V_lds = lds + LDS_V; LAS char* K_lds = lds + LDS_K;
    LAS float* ws = (LAS float*)(lds + LDS_WS) + wid * 64; LAS float* li_l = ws; LAS float* al_l = ws + 32;
    float m_reg = -1e30f, l_reg = 0; f32x16 o[2]; o[0] = f32x16{}; o[1] = f32x16{}; bf16x8 qr[6];
    const bf16* Qw = Q + (size_t)(qrow0 + wid * 32 + r32) * 768 + h * 96 + hi * 8;
#pragma unroll
    for (int d0 = 0; d0 < 6; ++d0) qr[d0] = *(const bf16x8*)(Qw + d0 * 16);
    {
        float qf[6][8]; float ss = 0.f;
#pragma unroll
        for (int d0 = 0; d0 < 6; ++d0) { const u32x4 w = __builtin_bit_cast(u32x4, qr[d0]);
            qf[d0][0] = bflo(w.x); qf[d0][1] = bfhi(w.x); qf[d0][2] = bflo(w.y); qf[d0][3] = bfhi(w.y); qf[d0][4] = bflo(w.z); qf[d0][5] = bfhi(w.z); qf[d0][6] = bflo(w.w); qf[d0][7] = bfhi(w.w);
#pragma unroll
            for (int j = 0; j < 8; ++j) ss += qf[d0][j] * qf[d0][j]; }
        { auto rr = __builtin_amdgcn_permlane32_swap(__float_as_uint(ss), __float_as_uint(ss), false, false); ss = __uint_as_float(rr[0]) + __uint_as_float(rr[1]); }
        const float rinv = (1.0f / sqrtf(ss * (1.0f / QKH) + EPS)) * (0.10206207261596577f * 1.4426950408889634f);
#pragma unroll
        for (int d0 = 0; d0 < 6; ++d0) { const f32x4 g0 = *(const f32x4*)(qgain + d0 * 16 + hi * 8), g1 = *(const f32x4*)(qgain + d0 * 16 + hi * 8 + 4);
#pragma unroll
            for (int j = 0; j < 4; ++j) { qf[d0][j] *= rinv * g0[j]; qf[d0][4 + j] *= rinv * g1[j]; } }
        if (qrope) { const float* rp = qrope + (size_t)(wid * 32 + r32) * 32 + hi * 8;
            const f32x4 c0 = *(const f32x4*)rp, c1 = *(const f32x4*)(rp + 4), s0 = *(const f32x4*)(rp + 16), s1 = *(const f32x4*)(rp + 20);
#pragma unroll
            for (int j = 0; j < 8; ++j) { const float c = j < 4 ? c0[j & 3] : c1[j & 3], sn = j < 4 ? s0[j & 3] : s1[j & 3]; const float x1 = qf[4][j], x2 = qf[5][j]; qf[4][j] = x1 * c - x2 * sn; qf[5][j] = x2 * c + x1 * sn; } }
#pragma unroll
        for (int d0 = 0; d0 < 6; ++d0) { u32x4 w; w.x = pk2(qf[d0][0], qf[d0][1]); w.y = pk2(qf[d0][2], qf[d0][3]); w.z = pk2(qf[d0][4], qf[d0][5]); w.w = pk2(qf[d0][6], qf[d0][7]); qr[d0] = __builtin_bit_cast(bf16x8, w); }
    }
    const int vr = tid >> 3, vc = tid & 7, vst = v_st(vr, vc * 8);
    const int kr0 = tid / 12, kc0_ = tid % 12, kr1 = (tid + 512) / 12, kc1_ = (tid + 512) % 12; const bool k2 = tid < 256;
    const int kst0 = KSWZ(kr0, kc0_ * 16), kst1 = KSWZ(kr1, kc1_ * 16);
    const bf16* Kh = K + h * 96; const bf16* Vh = V + h * 128 + 64;
    const int vb0 = (int)(uintptr_t)V_lds + v_rd_base(lane);
    struct { bf16x8 vs, ks0, ks1; } sr_[2];
#define TROW(j) ((j) < nx ? kx0 + (j) * 64 : kc0 + ((j) - nx) * 64)
#define SLOAD(i, j) do { const int t0_ = TROW(j); sr_[i].vs = *(const bf16x8*)(Vh + (size_t)(t0_ + vr) * 1024 + vc * 8); \
    sr_[i].ks0 = *(const bf16x8*)(Kh + (size_t)(t0_ + kr0) * 768 + kc0_ * 8); if (k2) sr_[i].ks1 = *(const bf16x8*)(Kh + (size_t)(t0_ + kr1) * 768 + kc1_ * 8); } while (0)
#define SWRITE(slot, i) do { *(LAS bf16x8*)(V_lds + (slot) * SHM_V + vst) = sr_[i].vs; *(LAS bf16x8*)(K_lds + (slot) * SHM_K + kst0) = sr_[i].ks0; \
    if (k2) *(LAS bf16x8*)(K_lds + (slot) * SHM_K + kst1) = sr_[i].ks1; } while (0)
#define RESC(a) do { if (!fixed) { if (__any((a) < 1.f)) { if (hi == 0) al_l[r32] = (a); asm volatile("s_waitcnt lgkmcnt(0)" ::: "memory"); \
    _Pragma("unroll") for (int d = 0; d < 2; ++d) _Pragma("unroll") for (int r = 0; r < 16; ++r) o[d][r] *= al_l[crow(r, hi)]; } } } while (0)
#define ROT() do { const int t_ = sp; sp = sc; sc = sn; sn = t_; } while (0)
    f32x16 pA0, pA1, pB0, pB1; float mnA, mnB, alA, alB; bf16x8 pa0, pa1, pa2, pa3;
    int sp = 0, sc = 1, sn = 2;
    SLOAD(0, 0); asm volatile("s_waitcnt vmcnt(0)" ::: "memory"); SWRITE(0, 0); SLOAD(1, 1); __syncthreads();
    qkt(pA0, pA1, K_lds, qr, r32, hi, negB); partialSM(pA0, pA1, m_reg, mnA, alA, fixed);
    SWRITE(1, 1); if (2 < NT) SLOAD(0, 2);
    __syncthreads();
    for (int j = 1; j + 1 < NT; j += 2) {
        SBAR(); qkt(pB0, pB1, K_lds + sc * SHM_K, qr, r32, hi, negB);
        finishSM(pA0, pA1, alA, l_reg, pa0, pa1, pa2, pa3); SBAR();
        SLOAD(1, j + 2); SBAR();
        pv_all(o, vb0 + sp * SHM_V, pa0, pa1, pa2, pa3); partialSM(pB0, pB1, m_reg, mnB, alB, fixed);
        SWRITE(sn, 0);
        RESC(alB); __syncthreads(); ROT();
        SBAR(); qkt(pA0, pA1, K_lds + sc * SHM_K, qr, r32, hi, negB);
        finishSM(pB0, pB1, alB, l_reg, pa0, pa1, pa2, pa3); SBAR();
        if (j + 3 < NT) SLOAD(0, j + 3); SBAR();
        pv_all(o, vb0 + sp * SHM_V, pa0, pa1, pa2, pa3); partialSM(pA0, pA1, m_reg, mnA, alA, fixed);
        SWRITE(sn, 1);
        RESC(alA); __syncthreads(); ROT();
    }
    SBAR(); qkt(pB0, pB1, K_lds + sc * SHM_K, qr, r32, hi, negB);
    finishSM(pA0, pA1, alA, l_reg, pa0, pa1, pa2, pa3); SBAR();
    pv_all(o, vb0 + sp * SHM_V, pa0, pa1, pa2, pa3); partialSM(pB0, pB1, m_reg, mnB, alB, fixed);
    RESC(alB);
    finishSM(pB0, pB1, alB, l_reg, pa0, pa1, pa2, pa3); SBAR();
    pv_all(o, vb0 + sc * SHM_V, pa0, pa1, pa2, pa3);
    if (hi == 0) li_l[r32] = l_reg; asm volatile("s_waitcnt lgkmcnt(0)" ::: "memory");
    bf16* Ow = O + (size_t)(qrow0 + wid * 32) * 1024 + h * 64 + r32;
#pragma unroll
    for (int r = 0; r < 16; ++r) { const int orow = crow(r, hi); const float rl = __builtin_amdgcn_rcpf(li_l[orow]);
#pragma unroll
        for (int d0 = 0; d0 < 2; ++d0) Ow[(size_t)orow * 1024 + d0 * 32] = (bf16)f2bf(o[d0][r] * rl); }
    __syncthreads();
#undef TROW
#undef SLOAD
#undef SWRITE
#undef RESC
#undef ROT
}
#undef KSWZ
#undef SBAR
}

enum { IX = 0, IC, ICTX, ICC, IADAW, IADAB, IMIXG, IFFNG, IWIN, IQLG, IKVLG, IWUQ, IWUKV, IQNG, IKNG, ICONVW, ICONVB, ICLNG, ICLNB, IWOUT, IFG, IFU, IFD, IRW, IMG, IMU, IMD, N_IN };
struct Args { const float* in[N_IN]; float* out; unsigned char* ws; int ph_lo, ph_hi; };
struct Frame {
    LAS unsigned char* lds; volatile LAS unsigned* MISC; gu32* ctl;
    int wave, G, gw, NGW;
    unsigned char* ws; float* out;
};
__device__ __forceinline__ const float* inp(int i) { asm volatile("" : "+s"(i)); return (const float*)((const GAS float* const*)__builtin_amdgcn_kernarg_segment_ptr())[i]; }
constexpr int CW_CNT = 8192;
constexpr int CW_SSQ = 16384;

__device__ __forceinline__ void transpose_tile(const float* __restrict__ W, int ldw, int k0, int n0, bf16* __restrict__ WT, int ldwt, int drow0, LAS float* scr, int lane, const float* kgain = nullptr) {
    const int n4 = (lane & 15) * 4, kq = lane >> 4;
    f32x4 v[16];
#pragma unroll
    for (int it = 0; it < 16; ++it) v[it] = *(const f32x4*)(W + (size_t)(k0 + 4 * it + kq) * ldw + n0 + n4);
#pragma unroll
    for (int it = 0; it < 16; ++it) { const int k = 4 * it + kq; if (kgain) v[it] = v[it] * kgain[k0 + k]; *(LAS f32x4*)(scr + k * 64 + (n4 ^ (((k >> 3) & 7) << 2))) = v[it]; }
    LDS_WAIT(); asm volatile("" ::: "memory");
    const int c = lane & 7;
#pragma unroll
    for (int it = 0; it < 8; ++it) { const int nn = (lane >> 3) + 8 * it; float s[8];
#pragma unroll
        for (int j = 0; j < 8; ++j) { const int k = 8 * c + j; s[j] = scr[k * 64 + (nn ^ (c << 2))]; }
        u32x4 o; o.x = pk2(s[0], s[1]); o.y = pk2(s[2], s[3]); o.z = pk2(s[4], s[5]); o.w = pk2(s[6], s[7]);
        *(u32x4*)(WT + (size_t)(drow0 + nn) * ldwt + k0 + 8 * c) = o; }
    LDS_WAIT(); asm volatile("" ::: "memory");
}
__device__ __forceinline__ int gu_row(int n, int up) { return (n >> 7) * 256 + up * 128 + (n & 127); }

constexpr int TT_IN = 16 * 19, TT_UQ = 6 * 12, TT_UKV = 4 * 16, TT_OUT = 16 * 16, TT_SMALL = 2 * (TT_IN + TT_UQ + TT_UKV + TT_OUT), TT_FF = 3 * 704, TT_ALL = TT_SMALL + 9 * TT_FF;
constexpr int FILL_P7 = 224 * 8 * 6;
__device__ __forceinline__ void transpose_item(unsigned char* ws, int it, LAS float* scr, int lane) {
    if (it < TT_SMALL) {
        const int l = it / (TT_SMALL / 2); int r = it % (TT_SMALL / 2);
        if (r < TT_IN) { const int nb = r % 19; int sc, dr;
            if (nb < 6) { sc = 64 * nb; dr = 64 * nb; } else if (nb == 6) { sc = 640; dr = C_KR; } else if (nb < 11) { sc = 384 + 64 * (nb - 7); dr = C_CKV + 64 * (nb - 7); }
            else if (nb < 13) { sc = 672 + 64 * (nb - 11); dr = 768 + 64 * (nb - 11); } else if (nb < 15) { sc = 928 + 64 * (nb - 13); dr = 896 + 64 * (nb - 13); }
            else if (nb < 17) { sc = 800 + 64 * (nb - 15); dr = 1024 + 64 * (nb - 15); } else { sc = 1056 + 64 * (nb - 17); dr = 1152 + 64 * (nb - 17); }
            transpose_tile(inp(IWIN) + (size_t)l * DM * INC, INC, (r / 19) * 64, sc, (bf16*)(ws + WS_WIN) + (size_t)l * NCOL * DM, DM, dr, scr, lane); return; } r -= TT_IN;
        if (r < TT_UQ) { transpose_tile(inp(IWUQ) + (size_t)l * QL * 768, 768, (r / 12) * 64, (r % 12) * 64, (bf16*)(ws + WS_WUQ) + (size_t)l * 768 * QL, QL, (r % 12) * 64, scr, lane, inp(IQLG) + l * QL); return; } r -= TT_UQ;
        if (r < TT_UKV) { transpose_tile(inp(IWUKV) + (size_t)l * KVL * 1024, 1024, (r / 16) * 64, (r % 16) * 64, (bf16*)(ws + WS_WUKV) + (size_t)l * 1024 * KVL, KVL, (r % 16) * 64, scr, lane, inp(IKVLG) + l * KVL); return; } r -= TT_UKV;
        transpose_tile(inp(IWOUT) + (size_t)l * DM * DM, DM, (r / 16) * 64, (r % 16) * 64, (bf16*)(ws + WS_WOUT) + (size_t)l * DM * DM, DM, (r % 16) * 64, scr, lane); return;
    }
    const int it2 = it - TT_SMALL, set = it2 / TT_FF, r = it2 % TT_FF, mat = r / 704, t = r % 704;
    const float* wg = set == 0 ? inp(IFG) : inp(IMG) + (size_t)(set - 1) * DM * DFF;
    const float* wu = set == 0 ? inp(IFU) : inp(IMU) + (size_t)(set - 1) * DM * DFF;
    const float* wd = set == 0 ? inp(IFD) : inp(IMD) + (size_t)(set - 1) * DFF * DM;
    bf16* dgu = set == 0 ? (bf16*)(ws + WS_WGU) : (bf16*)(ws + WS_MOEGU) + (size_t)(set - 1) * 2 * DFF * DM;
    bf16* dd = set == 0 ? (bf16*)(ws + WS_WD) : (bf16*)(ws + WS_MOED) + (size_t)(set - 1) * DM * DFF;
    if (mat < 2) { const int kb = t / 44, nb = t % 44; transpose_tile(mat == 0 ? wg : wu, DFF, kb * 64, nb * 64, dgu, DM, gu_row(nb * 64, mat), scr, lane); }
    else { const int kb = t / 16, nb = t % 16; transpose_tile(wd, DM, kb * 64, nb * 64, dd, DFF, nb * 64, scr, lane); }
}

__device__ __forceinline__ void prologue(const Args& a, Frame& F) {
    int lane_ = lane_id(), tid_ = F.wave * 64 + lane_; size_t z_ = 0; asm volatile("" : "+v"(lane_), "+v"(tid_), "+s"(z_)); unsigned char* ws_ = F.ws + z_;

    unsigned char* ws = ws_;
    LAS float* ldsf = (LAS float*)F.lds;
    for (int t = blockIdx.x; t < 192; t += F.G) {
        const int l = t / 96, cg = t % 96;
        for (int idx = tid_; idx < 9 * 1024; idx += 512) { const int bi = idx >> 10, k = idx & 1023; const float cv = bi < 8 ? inp(IC)[bi * 1024 + k] : inp(ICC)[k]; ldsf[idx] = cv / (1.0f + expf(-cv)); }
        __syncthreads();
        float acc[9];
#pragma unroll
        for (int bi = 0; bi < 9; ++bi) acc[bi] = 0.f;
        const float* wp = inp(IADAW) + ((size_t)l * 1024 + F.wave * 128) * 6144 + cg * 64 + lane_;
#pragma unroll 8
        for (int kk = 0; kk < 128; ++kk) { const float w = wp[(size_t)kk * 6144]; const int k = F.wave * 128 + kk;
#pragma unroll
            for (int bi = 0; bi < 9; ++bi) acc[bi] += ldsf[bi * 1024 + k] * w; }
        LAS float* red = ldsf + 9 * 1024;
#pragma unroll
        for (int bi = 0; bi < 9; ++bi) red[(F.wave * 9 + bi) * 64 + lane_] = acc[bi];
        __syncthreads();
        for (int idx = tid_; idx < 576; idx += 512) { const int bi = idx >> 6, c = idx & 63; float s = inp(IADAB)[l * 6144 + cg * 64 + c];
#pragma unroll
            for (int w = 0; w < 8; ++w) s += red[(w * 9 + bi) * 64 + c];
            ((float*)(ws + WS_MOD))[(size_t)(l * 9 + bi) * 6144 + cg * 64 + c] = s; }
        __syncthreads();
    }
    for (int t = blockIdx.x; t < 128; t += F.G) {
        const int l = t >> 6, g = (t >> 4) & 3, k0 = (t & 15) * 64;
        LAS float* Wl = ldsf; LAS float* tab = ldsf + 64 * 65;
        { const int k = tid_ >> 3, c8 = (tid_ & 7) * 8; const float* src = inp(IWIN) + ((size_t)l * DM + k0 + k) * INC + OFF_FOUR + g * 64 + c8;
          const f32x4 v0 = *(const f32x4*)src, v1 = *(const f32x4*)(src + 4);
#pragma unroll
          for (int e = 0; e < 4; ++e) { Wl[k * 65 + c8 + e] = v0[e]; Wl[k * 65 + c8 + 4 + e] = v1[e]; } }
        if (tid_ < 64) { tab[tid_] = cospif((float)tid_ / 32.0f); tab[64 + tid_] = sinpif((float)tid_ / 32.0f); }
        __syncthreads();
        const int k = tid_ & 63;
        for (int i = 0; i < 16; ++i) { const int pc = (tid_ >> 6) + 8 * i, part = pc >> 6, cp = pc & 63; float s = 0.f;
#pragma unroll 8
            for (int c = 0; c < 64; ++c) s += Wl[k * 65 + c] * tab[part * 64 + ((c * cp) & 63)];
            ((bf16*)(ws + WS_WFT))[((size_t)l * 512 + part * 256 + g * 64 + cp) * DM + k0 + k] = (bf16)f2bf(0.125f * s); }
        __syncthreads();
    }
    {
        LAS float* ctab = ldsf;
        for (int m = tid_; m < 2048; m += 512) ctab[m] = cospif((float)m / 1024.0f);
        __syncthreads();
        const float sc = 0.02209708691207961f;
        for (int k = blockIdx.x; k < 256; k += F.G) {
            if (tid_ < 64) { const int kk0 = tid_ * 8; unsigned w[4];
#pragma unroll
                for (int e = 0; e < 8; e += 2) { float v[2];
#pragma unroll
                    for (int q = 0; q < 2; ++q) { const int kk = kk0 + e + q; const int s = kk & 255; const int m = ((k * s) & 255) * 8; v[q] = kk < 256 ? ctab[m] * 0.0625f : -ctab[(m - 512) & 2047] * 0.0625f; }
                    w[e >> 1] = pk2(v[0], v[1]); }
                *(u32x4*)((bf16*)(ws + WS_DFTC) + (size_t)k * 512 + kk0) = (u32x4){w[0], w[1], w[2], w[3]}; }
        }
        __syncthreads();
    }
    for (int e = blockIdx.x * 512 + tid_; e < 2048 * 16; e += F.G * 512) { const int t = e >> 4, i = e & 15; const float pos = (float)(i < 8 ? (t >> 6) : (t & 63));
        const float inv = powf(10000.0f, -(float)(i & 7) * 0.125f); const float ang = pos * inv;
        ((float*)(ws + WS_ROPE))[t * 32 + i] = cosf(ang); ((float*)(ws + WS_ROPE))[t * 32 + 16 + i] = sinf(ang); }
    for (int e = blockIdx.x * 512 + tid_; e < 2 * 64 * DM / 8; e += F.G * 512) { const int l = e / (64 * DM / 8), r = e % (64 * DM / 8);
        *(u32x4*)((bf16*)(ws + WS_WIN) + ((size_t)l * NCOL + 448) * DM + (size_t)r * 8) = (u32x4){0u, 0u, 0u, 0u}; }
    { LAS float* scr = ldsf + F.wave * 4096;
      for (int it = F.gw; it < TT_ALL - FILL_P7; it += F.NGW) transpose_item(ws, it, scr, lane_); }
}

__device__ __forceinline__ const float* modp(const unsigned char* ws, int l, int bi, int which) { return (const float*)(ws + WS_MOD) + (size_t)(l * 9 + bi) * 6144 + which * 1024; }

template <bool ROUTER>
__device__ __forceinline__ void adaln_pass(const Frame& F, int l, int wsh, const float* gain, const float* srcx, const float* srcc, bool do_ctx, const float* router_w) {
    int lane_ = lane_id(), tid_ = F.wave * 64 + lane_; size_t z_ = 0; asm volatile("" : "+v"(lane_), "+v"(tid_), "+s"(z_)); unsigned char* ws_ = F.ws + z_;

    bf16* h = (bf16*)(ws_ + DY_H);
    LAS float* rwl = (LAS float*)F.lds;
    if (ROUTER) { for (int idx = tid_; idx < 8192; idx += 512) { const int k = idx >> 3, e = idx & 7; rwl[e * 1024 + k] = router_w[idx]; } __syncthreads(); }
    for (int gwi = F.gw; gwi < 2048; gwi += F.NGW) {
        for (int pass = 0; pass < (do_ctx ? 2 : 1); ++pass) {
            const int bi = pass == 0 ? (gwi >> 8) : 8;
            const float* sh = modp(ws_, l, bi, wsh); const float* sc = modp(ws_, l, bi, wsh + 1);
            f32x4 A[4], Bv[4];
#pragma unroll
            for (int j = 0; j < 4; ++j) { const int col = 256 * j + 4 * lane_; const f32x4 g4 = *(const f32x4*)(gain + col), s4 = *(const f32x4*)(sc + col); A[j] = g4 * (1.0f + s4); Bv[j] = *(const f32x4*)(sh + col); }
            const int nrow = pass == 0 ? 8 : 1;
            for (int rr = 0; rr < nrow; ++rr) {
                const int r = pass == 0 ? gwi * 8 + rr : gwi;
                const float* src = (pass == 0 ? srcx : srcc) + (size_t)r * DM;
                bf16* dst = h + (size_t)(pass == 0 ? r : RX + r) * DM;
                f32x4 v[4]; float ss = 0.f;
#pragma unroll
                for (int j = 0; j < 4; ++j) { v[j] = *(const f32x4*)(src + 256 * j + 4 * lane_); ss += (v[j].x * v[j].x + v[j].y * v[j].y) + (v[j].z * v[j].z + v[j].w * v[j].w); }
                const float rinv = 1.0f / sqrtf(wave_sum(ss) * (1.0f / DM) + EPS);
#pragma unroll
                for (int j = 0; j < 4; ++j) { v[j] = v[j] * rinv * A[j] + Bv[j];
                    u32x2 o; o.x = pk2(v[j].x, v[j].y); o.y = pk2(v[j].z, v[j].w); *(u32x2*)(dst + 256 * j + 4 * lane_) = o; }
                if (ROUTER) {
                    float lg[8];
#pragma unroll
                    for (int e = 0; e < 8; ++e) { float s = 0.f;
#pragma unroll
                        for (int j = 0; j < 4; ++j) { const f32x4 w4 = *(const LAS f32x4*)(rwl + e * 1024 + 256 * j + 4 * lane_); s += (v[j].x * w4.x + v[j].y * w4.y) + (v[j].z * w4.z + v[j].w * w4.w); }
                        lg[e] = wave_sum(s); }
                    int e0 = 0; float l0 = lg[0];
#pragma unroll
                    for (int e = 1; e < 8; ++e) if (lg[e] > l0) { l0 = lg[e]; e0 = e; }
                    int e1 = -1; float l1 = -3.0e38f;
#pragma unroll
                    for (int e = 0; e < 8; ++e) if (e != e0 && lg[e] > l1) { l1 = lg[e]; e1 = e; }
                    const float w0 = 1.0f / (1.0f + expf(l1 - l0));
                    if (lane_ == 0) { ((int*)(ws_ + WS_MOE + MO_TOKE))[r] = e0 | (e1 << 8); ((float*)(ws_ + WS_MOE + MO_TOKW))[2 * r] = w0; ((float*)(ws_ + WS_MOE + MO_TOKW))[2 * r + 1] = 1.0f - w0;
                        atomicAdd((int*)F.ctl + CW_CNT + (r >> 6) * 16 + e0, 1); atomicAdd((int*)F.ctl + CW_CNT + (r >> 6) * 16 + 8 + e1, 1); }
                }
            }
        }
    }
}

__device__ __forceinline__ void conv_pass(const Frame& F, const float* cw, const float* cb, const float* lg, const float* lb, const int wg0) {
    int lane_ = lane_id(), tid_ = F.wave * 64 + lane_; size_t z_ = 0; asm volatile("" : "+v"(lane_), "+v"(tid_), "+s"(z_)); unsigned char* ws_ = F.ws + z_;

    const bf16* y = (const bf16*)(ws_ + DY_Y); bf16* mix = (bf16*)(ws_ + DY_M);
    const int ch = 4 * lane_;
    LAS float* wl = (LAS float*)F.lds;
    __syncthreads();
    for (int idx = tid_; idx < 45 * CCH; idx += 512) { const int jj = idx >> 8; wl[idx] = (jj >= 7 && jj < 7 + CWID) ? cw[idx - 7 * CCH] : 0.f; }
    __syncthreads();
    const f32x4 bv = *(const f32x4*)(cb + ch), gv = *(const f32x4*)(lg + ch), bb = *(const f32x4*)(lb + ch);
    for (int ct = F.gw - wg0 * 8; ct < RT / 8; ct += F.NGW - wg0 * 8) {
        const int r0 = ct * 8;
        const int s0 = r0 < RX ? (r0 & ~(SEQ - 1)) : RX + ((r0 - RX) & ~(CTXL - 1)), s1 = s0 + (r0 < RX ? SEQ : CTXL);
        u32x2 yr[8 + CWID - 1];
#pragma unroll
        for (int i = 0; i < 8 + CWID - 1; ++i) { const int rr = r0 - 15 + i; yr[i] = (u32x2){0u, 0u}; if (rr >= s0 && rr < s1) yr[i] = *(const u32x2*)(y + (size_t)rr * CCH + ch); }
        f32x4 acc[8];
#pragma unroll
        for (int o = 0; o < 8; ++o) acc[o] = bv;
#pragma unroll
        for (int i = 0; i < 8 + CWID - 1; ++i) { const f32x4 yv = (f32x4){bflo(yr[i].x), bfhi(yr[i].x), bflo(yr[i].y), bfhi(yr[i].y)};
#pragma unroll
            for (int o = 0; o < 8; ++o) { const int j = i - o; if (j >= 0 && j < CWID) acc[o] += yv * *(const LAS f32x4*)(wl + (j + 7) * CCH + ch); } }
#pragma unroll
        for (int o = 0; o < 8; ++o) { const f32x4 v = acc[o];
            const float mean = wave_sum((v.x + v.y) + (v.z + v.w)) * (1.0f / CCH); const f32x4 d = v - mean;
            const float var = wave_sum((d.x * d.x + d.y * d.y) + (d.z * d.z + d.w * d.w)) * (1.0f / CCH); const float rs = 1.0f / sqrtf(var + EPS);
            const f32x4 n = d * rs * gv + bb;
            u32x2 w; w.x = pk2(siluf_(n.x), siluf_(n.y)); w.y = pk2(siluf_(n.z), siluf_(n.w));
            *(u32x2*)(mix + (size_t)(r0 + o) * DM + 512 + ch) = w; }
    }
}

__device__ __forceinline__ void fft_stage_a(const Frame& F) {
    int lane_ = lane_id(), tid_ = F.wave * 64 + lane_; size_t z_ = 0; asm volatile("" : "+v"(lane_), "+v"(tid_), "+s"(z_)); unsigned char* ws_ = F.ws + z_;
    LAS float* ctab = (LAS float*)F.lds;
    __syncthreads();
    for (int m = tid_; m < 2048; m += 512) ctab[m] = cospif((float)m / 1024.0f);
    __syncthreads();
    const float R = 0.70710678118654752f, IS8 = 0.35355339059327376f;
    const float c8[8] = {1.f, R, 0.f, -R, -1.f, -R, 0.f, R}, s8[8] = {0.f, R, 1.f, R, 0.f, -R, -1.f, -R};
    for (int row = F.gw; row < NB * 256; row += F.NGW) {
        bf16* zr = (bf16*)(ws_ + DY_Z) + (size_t)row * 4096 + 4 * lane_;
        float yr[8][4], yi[8][4];
#pragma unroll
        for (int s1 = 0; s1 < 8; ++s1) { const u32x2 a = *(const u32x2*)(zr + 256 * s1), b = *(const u32x2*)(zr + 2048 + 256 * s1);
            yr[s1][0] = bflo(a.x); yr[s1][1] = bfhi(a.x); yr[s1][2] = bflo(a.y); yr[s1][3] = bfhi(a.y);
            yi[s1][0] = -bflo(b.x); yi[s1][1] = -bfhi(b.x); yi[s1][2] = -bflo(b.y); yi[s1][3] = -bfhi(b.y); }
#pragma unroll
        for (int k1 = 0; k1 < 8; ++k1) { float pr[4], pi[4];
#pragma unroll
            for (int e = 0; e < 4; ++e) { float ar = 0.f, ai = 0.f;
#pragma unroll
                for (int s1 = 0; s1 < 8; ++s1) { const float c = c8[(k1 * s1) & 7], sn = s8[(k1 * s1) & 7]; ar += yr[s1][e] * c + yi[s1][e] * sn; ai += yi[s1][e] * c - yr[s1][e] * sn; }
                const int m = (k1 * (4 * lane_ + e)) & 2047; const float cb = ctab[m], sb = ctab[(m - 512) & 2047];
                pr[e] = (ar * cb + ai * sb) * IS8; pi[e] = -(ai * cb - ar * sb) * IS8; }
            u32x2 o0, o1; o0.x = pk2(pr[0], pr[1]); o0.y = pk2(pr[2], pr[3]); o1.x = pk2(pi[0], pi[1]); o1.y = pk2(pi[2], pi[3]);
            *(u32x2*)(zr + k1 * 512) = o0; *(u32x2*)(zr + k1 * 512 + 256) = o1; }
    }
}

__device__ __forceinline__ void t5_pass(const Frame& F, const float* qg, const float* kg) {
    int lane_ = lane_id(), tid_ = F.wave * 64 + lane_; size_t z_ = 0; asm volatile("" : "+v"(lane_), "+v"(tid_), "+s"(z_)); unsigned char* ws_ = F.ws + z_;

    bf16* q = (bf16*)(ws_ + DY_Q); const bf16* kvp = (const bf16*)(ws_ + DY_KV); const bf16* cols = (const bf16*)(ws_ + DY_C); bf16* kk = (bf16*)(ws_ + DY_K);
    const float* rope = (const float*)(ws_ + WS_ROPE);
    const int hh = lane_ >> 3, sub = lane_ & 7; const float QS = 0.10206207261596577f * 1.4426950408889634f;
    float gqn[8], gkn[8], gqr[4], gkr[4];
#pragma unroll
    for (int e = 0; e < 8; ++e) { gqn[e] = qg[8 * sub + e]; gkn[e] = kg[8 * sub + e]; }
#pragma unroll
    for (int e = 0; e < 2; ++e) { gqr[e] = qg[64 + 2 * sub + e]; gqr[2 + e] = qg[80 + 2 * sub + e]; gkr[e] = kg[64 + 2 * sub + e]; gkr[2 + e] = kg[80 + 2 * sub + e]; }
    for (int r = F.gw; r < RT; r += F.NGW) {
        float cs[2] = {1.f, 1.f}, sn[2] = {0.f, 0.f};
        if (r < RX) { const int t = r & (SEQ - 1); cs[0] = rope[t * 32 + 2 * sub]; cs[1] = rope[t * 32 + 2 * sub + 1]; sn[0] = rope[t * 32 + 16 + 2 * sub]; sn[1] = rope[t * 32 + 16 + 2 * sub + 1]; }
#pragma unroll
        for (int isk = 1; isk < 2; ++isk) {
            const bf16* pn = isk ? kvp + (size_t)r * 1024 + hh * 128 + 8 * sub : q + (size_t)r * 768 + hh * 96 + 8 * sub;
            const bf16* p1 = isk ? cols + (size_t)r * NC3 + C_KR + 2 * sub : q + (size_t)r * 768 + hh * 96 + 64 + 2 * sub;
            const u32x4 wn = *(const u32x4*)pn; const unsigned w1 = *(const unsigned*)p1, w2 = *(const unsigned*)(p1 + 16);
            float v[8] = {bflo(wn.x), bfhi(wn.x), bflo(wn.y), bfhi(wn.y), bflo(wn.z), bfhi(wn.z), bflo(wn.w), bfhi(wn.w)};
            float x1[2] = {bflo(w1), bfhi(w1)}, x2[2] = {bflo(w2), bfhi(w2)};
            float ss = x1[0] * x1[0] + x1[1] * x1[1] + x2[0] * x2[0] + x2[1] * x2[1];
#pragma unroll
            for (int e = 0; e < 8; ++e) ss += v[e] * v[e];
            ss = sum8(ss);
            const float rinv = (1.0f / sqrtf(ss * (1.0f / QKH) + EPS)) * (isk ? 1.0f : QS);
            const float* gn = isk ? gkn : gqn; const float* gr = isk ? gkr : gqr;
#pragma unroll
            for (int e = 0; e < 8; ++e) v[e] *= rinv * gn[e];
#pragma unroll
            for (int e = 0; e < 2; ++e) { x1[e] *= rinv * gr[e]; x2[e] *= rinv * gr[2 + e]; }
            const float o1a = x1[0] * cs[0] - x2[0] * sn[0], o1b = x1[1] * cs[1] - x2[1] * sn[1], o2a = x2[0] * cs[0] + x1[0] * sn[0], o2b = x2[1] * cs[1] + x1[1] * sn[1];
            bf16* dn = (isk ? kk : q) + (size_t)r * 768 + hh * 96;
            u32x4 o; o.x = pk2(v[0], v[1]); o.y = pk2(v[2], v[3]); o.z = pk2(v[4], v[5]); o.w = pk2(v[6], v[7]);
            *(u32x4*)(dn + 8 * sub) = o; *(unsigned*)(dn + 64 + 2 * sub) = pk2(o1a, o1b); *(unsigned*)(dn + 80 + 2 * sub) = pk2(o2a, o2b);
        }
    }
}

__device__ __forceinline__ void moe_assign(const Frame& F, int k) {
    int lane_ = lane_id(), tid_ = F.wave * 64 + lane_; size_t z_ = 0; asm volatile("" : "+v"(lane_), "+v"(tid_), "+s"(z_)); unsigned char* ws_ = F.ws + z_;
    LAS int* li = (LAS int*)F.lds;
    const int* cnt = (const int*)F.ctl + CW_CNT;
    const int* toke = (const int*)(ws_ + WS_MOE + MO_TOKE); const float* tokw = (const float*)(ws_ + WS_MOE + MO_TOKW);
    int* srow = (int*)(ws_ + WS_MOE + MO_SROW) + k * 32768; float* sw = (float*)(ws_ + WS_MOE + MO_SW) + k * 32768; int* meta = (int*)(ws_ + WS_MOE + MO_META) + 16 * k;
    const bf16* h = (const bf16*)(ws_ + DY_H); bf16* hg = (bf16*)(ws_ + DY_M);
    for (int rg = blockIdx.x; rg < 256; rg += F.G) {
        { const int e = F.wave; int tot = 0, bef = 0;
#pragma unroll
            for (int q = 0; q < 4; ++q) { const int g = 4 * lane_ + q; const int c = __hip_atomic_load(cnt + g * 16 + 8 * k + e, RLX_AGENT); tot += c; bef += g < rg ? c : 0; }
            tot = wave_isum(tot); bef = wave_isum(bef);
            if (lane_ == 0) { li[2048 + e] = tot; li[2056 + e] = bef; } }
        __syncthreads();
        if (tid_ == 0) { int pb = 0; for (int e = 0; e < 8; ++e) { li[2064 + e] = pb * 256; if (rg == 0) meta[e] = pb; pb += (li[2048 + e] + 255) >> 8; } li[2072] = pb * 256; if (rg == 0) meta[8] = pb; }
        __syncthreads();
        if (F.wave == 0) { const int r = rg * 64 + lane_; const int ek = (toke[r] >> (8 * k)) & 0xff; int rank = 0;
#pragma unroll
            for (int e = 0; e < 8; ++e) { const unsigned long long m = __ballot(ek == e); if (ek == e) rank = __popcll(m & ((1ull << lane_) - 1ull)); }
            const int slot = li[2064 + ek] + li[2056 + ek] + rank; srow[slot] = r; sw[slot] = tokw[2 * r + k]; li[2080 + lane_] = slot; }
        if (rg == 0) { for (int e = 0; e < 8; ++e) { const int b0 = li[2064 + e] + li[2048 + e], b1 = li[2064 + e + 1]; for (int s2 = b0 + tid_; s2 < b1; s2 += 512) { srow[s2] = -1; sw[s2] = 0.f; } } }
        __syncthreads();
        for (int i = F.wave * 8; i < F.wave * 8 + 8; ++i) { const int slot = li[2080 + i]; const u32x4* src = (const u32x4*)(h + (size_t)(rg * 64 + i) * DM); u32x4* dst = (u32x4*)(hg + (size_t)slot * DM);
            dst[lane_] = src[lane_]; dst[64 + lane_] = src[64 + lane_]; }
        __syncthreads();
    }
}

using pg8::Unit;
struct SchedIn {
    int G, c, l; unsigned char* ws;
    __device__ __forceinline__ bool next(int i, Unit& u) const { int L = i * G + c; if (L < 360) { u.pm = L / 5; u.pn = L % 5; return true; } L -= 360; if (L >= 144) return false; u.pm = 72 + L / 72; u.pn = L % 72; return true; }
    __device__ __forceinline__ const char* aptr(const Unit& u) const { return u.pm < 72 ? (const char*)(ws + DY_H) + (size_t)u.pm * 256 * DM * 2 : (const char*)(ws + WS_WFT) + ((size_t)l * 512 + (u.pm - 72) * 256) * DM * 2; }
    __device__ __forceinline__ const char* bptr(const Unit& u) const { return u.pm < 72 ? (const char*)(ws + WS_WIN) + ((size_t)l * NCOL + u.pn * 256) * DM * 2 : (const char*)(ws + DY_H) + (size_t)u.pn * 256 * DM * 2; }
};
struct EpiIn {
    static constexpr bool PERM = true; unsigned char* ws; float* ssq;
    __device__ __forceinline__ void operator()(const f32x4 (&acc)[2][2][4][2], const Unit& u, int wr, int wc, int fr, int fq) const {
        if (u.pm < 72) {
            bf16* C = (bf16*)(ws + DY_C) + (size_t)u.pm * 256 * NC3 + u.pn * 256;
            if (u.pn == 0) pg8::store_tile_bf16_ssq<2>(acc, C, NC3, ssq + (size_t)u.pm * 256 * 12 + wc, wr, wc, fr, fq);
            else if (u.pn == 1) pg8::store_tile_bf16_ssq<1>(acc, C, NC3, ssq + (size_t)u.pm * 256 * 12 + 4 + wc, wr, wc, fr, fq);
            else if (u.pn == 2) pg8::store_tile_bf16_ssq<2>(acc, C, NC3, ssq + (size_t)u.pm * 256 * 12 + 8 + wc, wr, wc, fr, fq);
            else pg8::store_tile_glu(acc, (bf16*)(ws + DY_Y) + (size_t)u.pm * 256 * CCH + (u.pn - 3) * 128, CCH, wr, wc, fr, fq);
        }
        else if (u.pn < 64) pg8::store_tile_bf16(acc, (bf16*)(ws + DY_Z) + ((size_t)(u.pn >> 3) * 256) * 4096 + (u.pm - 72) * 2048 + (u.pn & 7) * 256, 4096, wr, wc, fr, fq);
        else pg8::store_tile_bf16(acc, (bf16*)(ws + DY_Z + 16 * MiB) + (size_t)(u.pn - 64) * 256 * 512 + (u.pm - 72) * 256, 512, wr, wc, fr, fq);
    }
};
template <int LDC, int KDIM>
struct EpiUp {
    static constexpr bool PERM = true; bf16* C; const float* ssq;
    __device__ __forceinline__ void operator()(const f32x4 (&acc)[2][2][4][2], const Unit& u, int wr, int wc, int fr, int fq) const {
        pg8::store_tile_bf16_rs<KDIM == QL ? 8 : 4>(acc, C + (size_t)u.pm * 256 * LDC + u.pn * 256, LDC, ssq + (size_t)u.pm * 256 * 12, 1.0f / KDIM, wr, wc, fr, fq);
    }
};
template <int NPAN, int NTN, int LDA, int LDB, int ROT = 0>
struct SchedPlain {
    int G, c; const char* A; const char* B;
    __device__ __forceinline__ bool next(int i, Unit& u) const { const int cc = ROT ? (c + ROT) % G : c; const int L = i * G + cc; if (L >= NPAN * NTN) return false; u.pm = L / NTN; u.pn = L % NTN; return true; }
    __device__ __forceinline__ const char* aptr(const Unit& u) const { return A + (size_t)u.pm * 256 * LDA * 2; }
    __device__ __forceinline__ const char* bptr(const Unit& u) const { return B + (size_t)u.pn * 256 * LDB * 2; }
};
template <int LDC, bool SWIGLU>
struct EpiPlain {
    static constexpr bool PERM = true; bf16* C;
    __device__ __forceinline__ void operator()(const f32x4 (&acc)[2][2][4][2], const Unit& u, int wr, int wc, int fr, int fq) const {
        if (SWIGLU) pg8::store_tile_swiglu(acc, C + (size_t)u.pm * 256 * LDC + u.pn * 128, LDC, wr, wc, fr, fq);
        else pg8::store_tile_bf16(acc, C + (size_t)u.pm * 256 * LDC + u.pn * 256, LDC, wr, wc, fr, fq);
    }
};
struct SchedGUa {
    int G, c; const char* A; const char* B;
    __device__ __forceinline__ bool next(int i, Unit& u) const { const int L = i * G + c; if (L >= 256) return false; if (L < 176) { u.pm = 64 + L / 22; u.pn = L % 22; } else { const int j = L - 176; u.pm = j / 22; u.pn = j % 22; } return true; }
    __device__ __forceinline__ const char* aptr(const Unit& u) const { return A + (size_t)u.pm * 256 * DM * 2; }
    __device__ __forceinline__ const char* bptr(const Unit& u) const { return B + (size_t)u.pn * 256 * DM * 2; }
};
struct SchedGUb {
    int G, c; const char* A; const char* B;
    __device__ __forceinline__ bool next(int i, Unit& u) const {
        int j;
        if (G == 256) { if (c < 32) { if (i >= 3) return false; j = 80 + c * 3 + i; } else { j = 176 + (c - 32) + 224 * i; } }
        else j = 80 + i * G + c;
        if (j >= 64 * 22) return false; u.pm = j / 22; u.pn = j % 22; return true; }
    __device__ __forceinline__ const char* aptr(const Unit& u) const { return A + (size_t)u.pm * 256 * DM * 2; }
    __device__ __forceinline__ const char* bptr(const Unit& u) const { return B + (size_t)u.pn * 256 * DM * 2; }
};
template <int NPM, int K>
struct SchedDft {
    int G, c; const char* dft; const char* zt;
    __device__ __forceinline__ bool next(int i, Unit& u) const { const int L = i * G + c; if (L >= NB * NPM) return false; u.pm = L / NPM; u.pn = L % NPM; return true; }
    __device__ __forceinline__ const char* aptr(const Unit& u) const { return dft + (size_t)u.pn * 256 * K * 2; }
    __device__ __forceinline__ const char* bptr(const Unit& u) const { return zt + (size_t)u.pm * 256 * K * 2; }
};
template <int ROWS_PER_B>
struct EpiDft {
    static constexpr bool PERM = true; bf16* mix0;
    __device__ __forceinline__ void operator()(const f32x4 (&acc)[2][2][4][2], const Unit& u, int wr, int wc, int fr, int fq) const {
        pg8::store_tile_bf16(acc, mix0 + (size_t)(u.pm * ROWS_PER_B + u.pn * 256) * DM, DM, wr, wc, fr, fq);
    }
};
struct SchedFftC {
    int G, c; const char* dft; const char* zt;
    __device__ __forceinline__ bool next(int i, Unit& u) const { const int L = i * G + c; if (L >= NB * 8) return false; u.pm = L >> 3; u.pn = L & 7; return true; }
    __device__ __forceinline__ const char* aptr(const Unit&) const { return dft; }
    __device__ __forceinline__ const char* bptr(const Unit& u) const { return zt + ((size_t)u.pm * 256 * 4096 + u.pn * 512) * 2; }
};
struct EpiFftC {
    static constexpr bool PERM = true; bf16* mix0;
    __device__ __forceinline__ void operator()(const f32x4 (&acc)[2][2][4][2], const Unit& u, int wr, int wc, int fr, int fq) const {
        pg8::store_tile_bf16(acc, mix0 + (size_t)(u.pm * SEQ + u.pn) * DM, 8 * DM, wr, wc, fr, fq);
    }
};
template <int LDA>
struct SchedResid {
    int G, c, pm0, npan; const char* A; const char* B;
    __device__ __forceinline__ bool next(int i, Unit& u) const { const int L = i * G + c; if (L >= npan * 4) return false; u.pm = pm0 + (L >> 2); u.pn = L & 3; return true; }
    __device__ __forceinline__ const char* aptr(const Unit& u) const { return A + (size_t)u.pm * 256 * LDA * 2; }
    __device__ __forceinline__ const char* bptr(const Unit& u) const { return B + (size_t)u.pn * 256 * LDA * 2; }
};
struct EpiResid {
    static constexpr bool PERM = false;
    const float* xin; const float* cin; float* xout; float* cout; const float* gate;
    __device__ __forceinline__ void operator()(const f32x4 (&acc)[2][2][4][2], const Unit& u, int wr, int wc, int fr, int fq) const {
        if (u.pm < 64) { const size_t off = (size_t)u.pm * 256 * DM + u.pn * 256; pg8::store_tile_resid(acc, xin + off, xout + off, gate + (size_t)(u.pm >> 3) * 6144 + u.pn * 256, wr, wc, fr, fq); }
        else { const size_t off = (size_t)(u.pm - 64) * 256 * DM + u.pn * 256; pg8::store_tile_resid(acc, cin + off, cout + off, gate + (size_t)8 * 6144 + u.pn * 256, wr, wc, fr, fq); }
    }
};
template <int MODE>
struct SchedMoe {
    static constexpr bool DOWN = MODE >= 2;
    int G, c; const int* meta; unsigned char* ws;
    __device__ __forceinline__ bool next(int i, Unit& u) const {
        const int NP = __builtin_amdgcn_readfirstlane(meta[8]); int ned = 4 * NP - G; ned = ned < 0 ? 0 : ned; { const int cap = (G / 22) * 4; ned = ned > cap ? cap : ned; } ned &= ~3;
        if (MODE == 0) { const int L = i * G + c; if (i > 0 || L >= NP * 22) return false; u.pm = L / 22; u.pn = L % 22; return true; }
        if (MODE == 1) { int j; if (c < ned) { if (i >= 3) return false; j = G + c * 3 + i; } else { j = G + 3 * ned + (c - ned) + (G - ned) * i; } if (j >= NP * 22) return false; u.pm = j / 22; u.pn = j % 22; return true; }
        if (MODE == 2) { const int L = i * G + c; if (L >= ned) return false; u.pm = L >> 2; u.pn = L & 3; return true; }
        { const int L = i * G + c; const int ne = ned >> 2; if (L >= (NP - ne) * 4) return false; u.pm = ne + (L >> 2); u.pn = L & 3; return true; }
    }
    __device__ __forceinline__ int expert(int sp) const { int e = 0;
#pragma unroll
        for (int j = 1; j < 8; ++j) e += sp >= __builtin_amdgcn_readfirstlane(meta[j]) ? 1 : 0;
        return e; }
    __device__ __forceinline__ const char* aptr(const Unit& u) const { return DOWN ? (const char*)(ws + DY_ACT) + (size_t)u.pm * 256 * DFF * 2 : (const char*)(ws + DY_M) + (size_t)u.pm * 256 * DM * 2; }
    __device__ __forceinline__ const char* bptr(const Unit& u) const { const int e = expert(u.pm);
        return DOWN ? (const char*)(ws + WS_MOED) + ((size_t)e * DM + u.pn * 256) * DFF * 2 : (const char*)(ws + WS_MOEGU) + ((size_t)e * 2 * DFF + u.pn * 256) * DM * 2; }
};
struct EpiMoeDown {
    static constexpr bool PERM = false;
    const int* srow; const float* sw; const float* gate; float* out;
    __device__ __forceinline__ void operator()(const f32x4 (&acc)[2][2][4][2], const Unit& u, int wr, int wc, int fr, int fq) const {
        const int col0 = u.pn * 256 + wc * 32 + 4 * fq;
#pragma unroll
        for (int ai = 0; ai < 2; ++ai)
#pragma unroll
            for (int m = 0; m < 4; ++m) { const int slot = u.pm * 256 + ai * 128 + wr * 64 + m * 16 + fr; const int tok = srow[slot];
                if (tok >= 0) { const float w = sw[slot]; const float* g = gate + (size_t)(tok >> 11) * 6144 + col0; float* orow = out + (size_t)tok * DM + col0;
#pragma unroll
                    for (int bj = 0; bj < 2; ++bj)
#pragma unroll
                        for (int n = 0; n < 2; ++n) { const f32x4 gv = *(const f32x4*)(g + bj * 128 + n * 16); const f32x4 xv = *(const f32x4*)(orow + bj * 128 + n * 16);
                            *(f32x4*)(orow + bj * 128 + n * 16) = xv + gv * w * acc[ai][bj][m][n]; } } }
    }
};

#ifndef EN_MASK
#define EN_MASK 0xFFFFFFFFu
#endif
#ifndef PROBE_SITE
#define PROBE_SITE -1
#endif
#define RPT(n) for (int rep_ = 0; rep_ < ((PROBE_SITE) == (n) ? 2 : 1); ++rep_)
#define EN(n) (((EN_MASK) >> (n)) & 1u)
#define IN(k) (lo <= (k) && (k) < hi)
#define SEAM(k) do { if (!MK_PER_PHASE && IN(k) && IN((k) + 1)) xcd_barrier(bar); } while (0)
#define SITE if (PROBE_SITE >= 0 && rep_ > 0) xcd_barrier(bar); size_t z_ = 0; int cid = blockIdx.x, G = gridDim.x; if ((G & 7) == 0) cid = (cid & 7) * (G >> 3) + (cid >> 3); asm volatile("" : "+s"(z_), "+s"(cid), "+s"(G)); unsigned char* ws = a.ws + z_;

template <int L>
__device__ __forceinline__ void mixer_phases(const Args& a, Frame& F, const XcdBarrier& bar, const int lo, const int hi) {
    constexpr int rep_ = 0; (void)rep_;
    constexpr int P = L == 0 ? 1 : 11;
    LAS unsigned char* ring = F.lds;
    RPT(1) if (EN(1) && IN(P + 0)) { SITE adaln_pass<false>(F, L, 0, inp(IMIXG) + L * DM, L == 0 ? inp(IX) : ((float*)(GAS float*)a.out), L == 0 ? inp(ICTX) : (const float*)(ws + WS_CTXS), true, nullptr); } SEAM(P + 0);
    RPT(2) if (EN(2) && IN(P + 1)) { SITE
        SchedIn S{G, cid, L, ws};
        pg8::gemm_phase(ring, F.wave, pg8::GemmK{DM, DM, DM}, S, EpiIn{ws, (float*)(ws + WS_SSQP) + (size_t)L * RT * 12});
    } SEAM(P + 1);
    RPT(4) if (EN(4) && IN(P + 2)) { SITE
        SchedPlain<72, 3, NC3, QL> S{G, cid, (const char*)(ws + DY_C), (const char*)(ws + WS_WUQ) + (size_t)L * 768 * QL * 2};
        pg8::gemm_phase(ring, F.wave, pg8::GemmK{NC3, QL, QL}, S, EpiUp<768, QL>{(bf16*)(ws + DY_Q), (const float*)(ws + WS_SSQP) + (size_t)L * RT * 12}); }
    RPT(17) if (EN(17) && IN(P + 2)) { SITE
        SchedPlain<72, 4, NC3, KVL, 40> S{G, cid, (const char*)(ws + DY_C) + C_CKV * 2, (const char*)(ws + WS_WUKV) + (size_t)L * 1024 * KVL * 2};
        pg8::gemm_phase(ring, F.wave, pg8::GemmK{NC3, KVL, KVL}, S, EpiUp<1024, KVL>{(bf16*)(ws + DY_KV), (const float*)(ws + WS_SSQP) + (size_t)L * RT * 12 + 8}); }
    if (L == 0) { RPT(16) if (EN(16) && IN(P + 2)) { SITE
        SchedDft<1, 512> S{G, (cid + 8) % G, (const char*)(ws + WS_DFTC), (const char*)(ws + DY_Z + 16 * MiB)};
        pg8::gemm_phase(ring, F.wave, pg8::GemmK{512, 512, 512}, S, EpiDft<CTXL>{(bf16*)(ws + DY_M) + (size_t)RX * DM + 768}); } }
    RPT(18) if (EN(18) && IN(P + 2)) { SITE conv_pass(F, inp(ICONVW) + L * CWID * CCH, inp(ICONVB) + L * CCH, inp(ICLNG) + L * CCH, inp(ICLNB) + L * CCH, 0); }
    RPT(15) if (EN(15) && IN(P + 2)) { SITE fft_stage_a(F); }
    SEAM(P + 2);
    if (EN(23) && IN(P + 3)) { SITE
        SchedFftC S{G, cid, (const char*)(ws + WS_DFTC), (const char*)(ws + DY_Z)};
        pg8::gemm_phase(ring, F.wave, pg8::GemmK{512, 4096, 512}, S, EpiFftC{(bf16*)(ws + DY_M) + 768}); }
    if (EN(5) && IN(P + 3)) { SITE t5_pass(F, inp(IQNG) + L * QKH, inp(IKNG) + L * QKH); } SEAM(P + 3);
    RPT(6) if (EN(6) && IN(P + 4)) { SITE
        const bf16* Q = (const bf16*)(ws + DY_Q); const bf16* K = (const bf16*)(ws + DY_K); const bf16* V = (const bf16*)(ws + DY_KV); bf16* O = (bf16*)(ws + DY_M);
        float mq, mk; { const int ln = lane_id(); const float* gq = inp(IQNG) + L * QKH; const float* gk = inp(IKNG) + L * QKH;
            float a = fmaxf(fabsf(gq[ln]), ln < 32 ? fabsf(gq[64 + ln]) : 0.f), b = fmaxf(fabsf(gk[ln]), ln < 32 ? fabsf(gk[64 + ln]) : 0.f);
#pragma unroll
            for (int o = 1; o < 64; o <<= 1) { a = fmaxf(a, __shfl_xor(a, o)); b = fmaxf(b, __shfl_xor(b, o)); }
            mq = __builtin_bit_cast(float, __builtin_amdgcn_readfirstlane(__builtin_bit_cast(int, a))); mk = __builtin_bit_cast(float, __builtin_amdgcn_readfirstlane(__builtin_bit_cast(int, b))); }
        const float B = 1.02f * 1.4426950408889634f * 9.797958971132712f * mq * mk; const bool fixed = B <= 60.0f; const float negB = fixed ? -B : 0.f;
        for (int u = cid; u < 512; u += G) { const int b = u >> 6, hh = (u >> 3) & 7, qb = u & 7; att::attn_unit(Q, K, V, O, b * SEQ + qb * 256, hh, 36, 32, b * SEQ, RX + b * CTXL, (LAS char*)ring, F.wave, negB, fixed, inp(IQNG) + L * QKH, (const float*)(ws + WS_ROPE) + (size_t)qb * 256 * 32); }
        if (L == 0) { for (int u = cid; u < 64; u += G) { const int b = u >> 3, hh = u & 7; att::attn_unit(Q, K, V, O, RX + b * CTXL, hh, 4, 0, 0, RX + b * CTXL, (LAS char*)ring, F.wave, negB, fixed, inp(IQNG) + L * QKH, nullptr); } }
    }
    SEAM(P + 4);
    if (EN(7) && IN(P + 5)) { SITE
        SchedResid<DM> S{G, cid, 0, L == 0 ? 72 : 64, (const char*)(ws + DY_M), (const char*)(ws + WS_WOUT) + (size_t)L * DM * DM * 2};
        EpiResid E{L == 0 ? inp(IX) : ((float*)(GAS float*)a.out), L == 0 ? inp(ICTX) : (const float*)(ws + WS_CTXS), ((float*)(GAS float*)a.out), (float*)(ws + WS_CTXS), modp(ws, L, 0, 2)};
        pg8::gemm_phase(ring, F.wave, pg8::GemmK{DM, DM, DM}, S, E);
        if (L == 0 && G == 256 && cid >= 32) {
            const int ln = lane_id();
            for (int j = 0; j < 6; ++j) transpose_item(ws, TT_ALL - FILL_P7 + ((cid - 32) * 8 + F.wave) * 6 + j, (LAS float*)F.lds + F.wave * 4096, ln); }
        if (L == 0 && G != 256) { const int ln = lane_id(); for (int it = TT_ALL - FILL_P7 + F.gw; it < TT_ALL; it += F.NGW) transpose_item(ws, it, (LAS float*)F.lds + F.wave * 4096, ln); }
    } SEAM(P + 5);
}
template <int K>
__device__ __forceinline__ void moe_round(const Args& a, Frame& F, const XcdBarrier& bar, const int lo, const int hi) {
    constexpr int rep_ = 0; (void)rep_;
    constexpr int P = K == 0 ? 18 : 21;
    LAS unsigned char* ring = F.lds;
    if (K == 0) { RPT(12) if (EN(12) && IN(P + 0)) { SITE moe_assign(F, 0); } SEAM(P + 0); }
    RPT(13) if (EN(13) && IN(P + 1)) { SITE
        SchedMoe<0> S{G, cid, (const int*)(ws + WS_MOE + MO_META) + 16 * K, ws};
        pg8::gemm_phase(ring, F.wave, pg8::GemmK{DM, DM, DM}, S, EpiPlain<DFF, true>{(bf16*)(ws + DY_ACT)});
    } SEAM(P + 1);
    if (EN(14) && IN(P + 2)) { SITE
        SchedMoe<2> S{G, cid, (const int*)(ws + WS_MOE + MO_META) + 16 * K, ws};
        EpiMoeDown E{(const int*)(ws + WS_MOE + MO_SROW) + K * 32768, (const float*)(ws + WS_MOE + MO_SW) + K * 32768, modp(ws, 1, 0, 5), ((float*)(GAS float*)a.out)};
        pg8::gemm_phase(ring, F.wave, pg8::GemmK{DFF, DFF, DFF}, S, E);
    }
    if (EN(19) && IN(P + 2)) { SITE
        SchedMoe<1> S{G, cid, (const int*)(ws + WS_MOE + MO_META) + 16 * K, ws};
        pg8::gemm_phase(ring, F.wave, pg8::GemmK{DM, DM, DM}, S, EpiPlain<DFF, true>{(bf16*)(ws + DY_ACT)});
    } SEAM(P + 2);
    if (EN(20) && IN(P + 3)) { SITE
        SchedMoe<3> S{G, cid, (const int*)(ws + WS_MOE + MO_META) + 16 * K, ws};
        EpiMoeDown E{(const int*)(ws + WS_MOE + MO_SROW) + K * 32768, (const float*)(ws + WS_MOE + MO_SW) + K * 32768, modp(ws, 1, 0, 5), ((float*)(GAS float*)a.out)};
        pg8::gemm_phase(ring, F.wave, pg8::GemmK{DFF, DFF, DFF}, S, E);
    }
    if (K == 0) { if (EN(12) && IN(P + 3)) { SITE moe_assign(F, 1); } }
    SEAM(P + 3);
}

__global__ void __launch_bounds__(512, 2) fwd(Args a) {
    extern __shared__ __attribute__((aligned(16))) unsigned char lds_raw[];
    Frame F;
    F.lds = (LAS unsigned char*)lds_raw; F.MISC = (volatile LAS unsigned*)(F.lds + MISC_OFF);
    F.wave = __builtin_amdgcn_readfirstlane((int)threadIdx.x >> 6);
    F.G = gridDim.x; F.gw = blockIdx.x * 8 + F.wave; F.NGW = F.G * 8; F.ws = a.ws; F.out = a.out;
    F.ctl = (gu32*)(a.ws + WS_CTL);
    for (int u = F.wave * 64 + lane_id(); u < (LDS_BYTES - LDSCTL_OFF) / 4; u += 512) ((LAS unsigned*)(F.lds + LDSCTL_OFF))[u] = 0u;
    __syncthreads();
    XcdBarrier bar; bar.bar = (unsigned*)(F.ctl + CW_BAR); bar.x = 0; bar.st = nullptr; bar.wave = F.wave;
    if (!MK_PER_PHASE) bar = xcd_barrier_post((unsigned*)(F.ctl + CW_BAR), F.MISC + 8, F.wave);
    const int lo = a.ph_lo, hi = a.ph_hi;
    LAS unsigned char* ring = F.lds;
    constexpr int rep_ = 0; (void)rep_;

    RPT(0) if (EN(0) && IN(0)) { if (PROBE_SITE >= 0 && rep_ > 0) xcd_barrier(bar); prologue(a, F); } SEAM(0);
    mixer_phases<0>(a, F, bar, lo, hi);
    RPT(8) if (EN(8) && IN(7)) { SITE adaln_pass<false>(F, 0, 3, inp(IFFNG), ((float*)(GAS float*)a.out), (const float*)(ws + WS_CTXS), true, nullptr); } SEAM(7);
    RPT(9) if (EN(9) && IN(8)) { SITE
        SchedGUa S{G, cid, (const char*)(ws + DY_H), (const char*)(ws + WS_WGU)};
        pg8::gemm_phase(ring, F.wave, pg8::GemmK{DM, DM, DM}, S, EpiPlain<DFF, true>{(bf16*)(ws + DY_ACT)});
    } SEAM(8);
    if (EN(10) && IN(9)) { SITE
        SchedResid<DFF> S{G, cid, 64, 8, (const char*)(ws + DY_ACT), (const char*)(ws + WS_WD)};
        EpiResid E{((float*)(GAS float*)a.out), (const float*)(ws + WS_CTXS), ((float*)(GAS float*)a.out), (float*)(ws + WS_CTXS), modp(ws, 0, 0, 5)};
        pg8::gemm_phase(ring, F.wave, pg8::GemmK{DFF, DFF, DFF}, S, E);
    }
    if (EN(21) && IN(9)) { SITE
        SchedGUb S{G, cid, (const char*)(ws + DY_H), (const char*)(ws + WS_WGU)};
        pg8::gemm_phase(ring, F.wave, pg8::GemmK{DM, DM, DM}, S, EpiPlain<DFF, true>{(bf16*)(ws + DY_ACT)});
    } SEAM(9);
    if (EN(22) && IN(10)) { SITE
        SchedResid<DFF> S{G, cid, 0, 64, (const char*)(ws + DY_ACT), (const char*)(ws + WS_WD)};
        EpiResid E{((float*)(GAS float*)a.out), (const float*)(ws + WS_CTXS), ((float*)(GAS float*)a.out), (float*)(ws + WS_CTXS), modp(ws, 0, 0, 5)};
        pg8::gemm_phase(ring, F.wave, pg8::GemmK{DFF, DFF, DFF}, S, E);
    } SEAM(10);
    mixer_phases<1>(a, F, bar, lo, hi);
    RPT(11) if (EN(11) && IN(17)) { SITE adaln_pass<true>(F, 1, 3, inp(IFFNG) + DM, ((float*)(GAS float*)a.out), nullptr, false, inp(IRW)); } SEAM(17);
    moe_round<0>(a, F, bar, lo, hi);
    moe_round<1>(a, F, bar, lo, hi);
}
#undef IN
#undef SEAM
#undef SITE

extern "C" void kernel_launch(void* const* d_in, const int* in_sizes, int n_in, void* d_out, int out_size, void* d_ws, size_t ws_size, hipStream_t stream) {
    static int grid = 0;
    if (grid == 0) {
        if (n_in != N_IN || out_size != RX * DM || ws_size < WS_END) { fprintf(stderr, "kernel_launch: unexpected shapes (n_in %d out %d ws %zu, need ws >= %zu)\n", n_in, out_size, ws_size, (size_t)WS_END); grid = -1; return; }
        int dev = 0, cus = 0, per_cu = 0;
        if (hipGetDevice(&dev) != hipSuccess || hipDeviceGetAttribute(&cus, hipDeviceAttributeMultiprocessorCount, dev) != hipSuccess) { grid = -1; return; }
        if (hipFuncSetAttribute((const void*)fwd, hipFuncAttributeMaxDynamicSharedMemorySize, LDS_BYTES) != hipSuccess) { fprintf(stderr, "kernel_launch: hipFuncSetAttribute failed\n"); grid = -1; return; }
        if (hipOccupancyMaxActiveBlocksPerMultiprocessor(&per_cu, (const void*)fwd, 512, LDS_BYTES) != hipSuccess || per_cu < 1) fprintf(stderr, "kernel_launch: occupancy query reports %d\n", per_cu);
        (void)hipGetLastError();
        grid = cus;
    }
    if (grid < 0) return;
    (void)hipMemsetAsync((char*)d_ws + WS_CTL, 0, CTL_ZERO_BYTES, stream);
    Args a{};
    for (int i = 0; i < N_IN; ++i) a.in[i] = (const float*)d_in[i];
    a.out = (float*)d_out; a.ws = (unsigned char*)d_ws;
#if MK_PER_PHASE
    for (int p = 0; p < N_PHASES; ++p) { a.ph_lo = p; a.ph_hi = p + 1; hipLaunchKernelGGL(fwd, dim3(grid), dim3(512), LDS_BYTES, stream, a); }
#else
    a.ph_lo = 0; a.ph_hi = N_PHASES;
    hipLaunchKernelGGL(fwd, dim3(grid), dim3(512), LDS_BYTES, stream, a);
#endif
}
```
